# Optimizing an MI355X kernel written in HIP

```python
import math
import jax
import jax.numpy as jnp
from jax import lax
import numpy as np

D_MODEL = 1024
BATCH = 8
SEQ = 2048
DEPTH = 2
DEC_BATCH = 16
DEC_SEQ = 4096
PAST_LEN = 128

HEAD_DIM = 64
A_GROUPS = 4
A_WIDTH = A_GROUPS * HEAD_DIM
CHUNK = 128
B_HEADS = 4
B_WIDTH = B_HEADS * 2 * HEAD_DIM
C_HEADS = 4
C_WIDTH = C_HEADS * HEAD_DIM
MIX_WIDTH = A_WIDTH + B_WIDTH + C_WIDTH
IN_WIDTH = 2 * A_WIDTH + 3 * B_WIDTH + 3 * C_WIDTH
GRID_W = 64
NA_ROWS_MAX = 8
NA_COLS = 16
RPB_ROWS = 2 * NA_ROWS_MAX - 1
RPB_COLS = 2 * NA_COLS - 1
D_FF = ((8 * D_MODEL // 3 + 255) // 256) * 256
DEEPNORM_ALPHA = (2 * DEPTH) ** 0.25
DEEPNORM_BETA = (8 * DEPTH) ** -0.25
LN_EPS = 1e-5
Q_BLOCK = 128

kernel_name = 'hybrid_gmlp_diffattn_natten_encoder'


def layer_norm(x, g, b):
    xf = x.astype(jnp.float32)
    mu = jnp.mean(xf, axis=-1, keepdims=True)
    xc = xf - mu
    var = jnp.mean(jnp.square(xc), axis=-1, keepdims=True)
    return (xc * lax.rsqrt(var + LN_EPS) * g + b).astype(x.dtype)


def rms_norm(x, g):
    xf = x.astype(jnp.float32)
    ms = jnp.mean(jnp.square(xf), axis=-1, keepdims=True)
    return (xf * lax.rsqrt(ms + LN_EPS) * g).astype(x.dtype)


def split_projection(h):
    sizes = [A_WIDTH, A_WIDTH, B_WIDTH, B_WIDTH, B_WIDTH, C_WIDTH, C_WIDTH, C_WIDTH]
    idx = np.cumsum(sizes)[:-1].tolist()
    return jnp.split(h, idx, axis=-1)


def spatial_gating(u, v, ln_g, ln_b, w_s, b_s):
    bsz, s, _ = u.shape
    v = layer_norm(v, ln_g, ln_b)
    vc = v.reshape(bsz, s // CHUNK, CHUNK, A_GROUPS, HEAD_DIM)
    mixed = jnp.einsum('gts,bnsgc->bntgc', w_s, vc) + jnp.transpose(b_s)[None, None, :, :, None]
    return u * mixed.reshape(bsz, s, A_WIDTH)


def differential_attention(q, k, v, lam, lam_init, subln_g):
    bsz, s = q.shape[0], q.shape[1]
    nb = s // Q_BLOCK
    scale = HEAD_DIM ** -0.5
    slopes = jnp.exp2(-8.0 * jnp.arange(1, B_HEADS + 1, dtype=jnp.float32) / B_HEADS)
    kpos = jnp.arange(s)
    qb = jnp.transpose((q * scale).reshape(bsz, nb, Q_BLOCK, B_HEADS, 2, HEAD_DIM), (1, 0, 2, 3, 4, 5))

    def block(args):
        qi, i = args
        sc = jnp.einsum('bqhcd,bkhcd->bchqk', qi, k, preferred_element_type=jnp.float32)
        qpos = i * Q_BLOCK + jnp.arange(Q_BLOCK)
        dist = jnp.abs(qpos[:, None] - kpos[None, :]).astype(jnp.float32)
        p = jax.nn.softmax(sc - slopes[:, None, None] * dist, axis=-1)
        attn = p[:, 0] - lam * p[:, 1]
        return jnp.einsum('bhqk,bkhe->bqhe', attn.astype(v.dtype), v)

    out = lax.map(block, (qb, jnp.arange(nb)))
    out = jnp.transpose(out, (1, 0, 2, 3, 4)).reshape(bsz, s, B_HEADS, 2 * HEAD_DIM)
    out = rms_norm(out, subln_g) * (1.0 - lam_init)
    return out.reshape(bsz, s, B_WIDTH)


def neighbourhood_attention(q, k, v, rpb):
    bsz, s = q.shape[0], q.shape[1]
    rows = s // GRID_W
    wr = min(NA_ROWS_MAX, rows)
    wc = NA_COLS
    scale = HEAD_DIM ** -0.5
    qg = jnp.transpose((q * scale).reshape(bsz, rows, GRID_W, C_HEADS, HEAD_DIM), (1, 0, 2, 3, 4))
    kg = k.reshape(bsz, rows, GRID_W, C_HEADS, HEAD_DIM)
    vg = v.reshape(bsz, rows, GRID_W, C_HEADS, HEAD_DIM)
    col = jnp.arange(GRID_W)
    col_start = jnp.clip(col - wc // 2, 0, GRID_W - wc)
    key_cols = col_start[:, None] + jnp.arange(wc)[None, :]
    col_off = key_cols - col[:, None] + (NA_COLS - 1)

    def row_block(args):
        qr, r = args
        r_start = jnp.clip(r - wr // 2, 0, rows - wr)
        kr = lax.dynamic_slice_in_dim(kg, r_start, wr, axis=1)
        vr = lax.dynamic_slice_in_dim(vg, r_start, wr, axis=1)
        kn = kr[:, :, key_cols]
        vn = vr[:, :, key_cols]
        row_off = r_start + jnp.arange(wr) - r + (NA_ROWS_MAX - 1)
        bias = rpb[:, row_off[:, None, None], col_off[None, :, :]]
        sc = jnp.einsum('bqhd,biqjhd->bhqij', qr, kn, preferred_element_type=jnp.float32)
        sc = sc + jnp.transpose(bias, (0, 2, 1, 3)).astype(jnp.float32)[None]
        p = jax.nn.softmax(sc.reshape(bsz, C_HEADS, GRID_W, wr * wc), axis=-1)
        p = p.reshape(bsz, C_HEADS, GRID_W, wr, wc)
        return jnp.einsum('bhqij,biqjhd->bqhd', p.astype(vn.dtype), vn)

    out = lax.map(row_block, (qg, jnp.arange(rows)))
    return jnp.transpose(out, (1, 0, 2, 3, 4)).reshape(bsz, s, C_WIDTH)


def token_mix(x, layer, w_in, w_out, a_ln_g, a_ln_b, a_w_s, a_b_s, lq1, lk1, lq2, lk2, subln_g, rpb):
    bsz, s, _ = x.shape
    h = x @ w_in
    a_u, a_v, b_q, b_k, b_v, c_q, c_k, c_v = split_projection(h)
    out_a = spatial_gating(jax.nn.gelu(a_u), jax.nn.gelu(a_v), a_ln_g, a_ln_b, a_w_s, a_b_s)
    lam_init = 0.8 - 0.6 * math.exp(-0.3 * layer)
    lam = (jnp.exp(jnp.sum(lq1.astype(jnp.float32) * lk1.astype(jnp.float32)))
           - jnp.exp(jnp.sum(lq2.astype(jnp.float32) * lk2.astype(jnp.float32))) + lam_init)
    out_b = differential_attention(
        b_q.reshape(bsz, s, B_HEADS, 2, HEAD_DIM),
        b_k.reshape(bsz, s, B_HEADS, 2, HEAD_DIM),
        b_v.reshape(bsz, s, B_HEADS, 2 * HEAD_DIM),
        lam, lam_init, subln_g)
    out_c = neighbourhood_attention(
        c_q.reshape(bsz, s, C_HEADS, HEAD_DIM),
        c_k.reshape(bsz, s, C_HEADS, HEAD_DIM),
        c_v.reshape(bsz, s, C_HEADS, HEAD_DIM), rpb)
    return jnp.concatenate([out_a, out_b, out_c], axis=-1) @ w_out


def swiglu(x, w_gate, w_up, w_down):
    return (jax.nn.silu(x @ w_gate) * (x @ w_up)) @ w_down


def trunk(x, w_in, w_out, a_ln_g, a_ln_b, a_w_s, a_b_s, b_lambda_q1, b_lambda_k1, b_lambda_q2,
          b_lambda_k2, b_subln_g, c_rpb, w_gate, w_up, w_down, ln_g, ln_b):
    for l in range(DEPTH):
        mix = token_mix(x, l, w_in[l], w_out[l], a_ln_g[l], a_ln_b[l], a_w_s[l], a_b_s[l],
                        b_lambda_q1[l], b_lambda_k1[l], b_lambda_q2[l], b_lambda_k2[l],
                        b_subln_g[l], c_rpb[l])
        x = layer_norm(DEEPNORM_ALPHA * x + mix, ln_g[l, 0], ln_b[l, 0])
        x = layer_norm(DEEPNORM_ALPHA * x + swiglu(x, w_gate[l], w_up[l], w_down[l]), ln_g[l, 1], ln_b[l, 1])
    return x


def setup_inputs(seed: int = 0) -> dict:
    key = jax.random.key(seed)
    ks = jax.random.split(key, 20)
    f32 = jnp.float32

    def nrm(k, shape, scale):
        return jax.random.normal(k, shape, f32) * scale

    x_prompt = nrm(ks[0], (BATCH, SEQ, D_MODEL), 1.0)
    x_sample = nrm(ks[1], (DEC_BATCH, DEC_SEQ, D_MODEL), 1.0)
    col_scale = jnp.concatenate([
        jnp.ones((2 * A_WIDTH + 2 * B_WIDTH,), f32),
        jnp.full((B_WIDTH,), DEEPNORM_BETA, f32),
        jnp.ones((2 * C_WIDTH,), f32),
        jnp.full((C_WIDTH,), DEEPNORM_BETA, f32)])
    w_in = nrm(ks[2], (DEPTH, D_MODEL, IN_WIDTH), D_MODEL ** -0.5) * col_scale
    w_out = nrm(ks[3], (DEPTH, MIX_WIDTH, D_MODEL), MIX_WIDTH ** -0.5 * DEEPNORM_BETA)
    a_ln_g = 1.0 + nrm(ks[4], (DEPTH, A_WIDTH), 0.02)
    a_ln_b = nrm(ks[5], (DEPTH, A_WIDTH), 0.02)
    a_w_s = nrm(ks[6], (DEPTH, A_GROUPS, CHUNK, CHUNK), CHUNK ** -0.5)
    a_b_s = 1.0 + nrm(ks[7], (DEPTH, A_GROUPS, CHUNK), 0.02)
    b_lambda_q1 = nrm(ks[8], (DEPTH, HEAD_DIM), 0.1)
    b_lambda_k1 = nrm(ks[9], (DEPTH, HEAD_DIM), 0.1)
    b_lambda_q2 = nrm(ks[10], (DEPTH, HEAD_DIM), 0.1)
    b_lambda_k2 = nrm(ks[11], (DEPTH, HEAD_DIM), 0.1)
    b_subln_g = 1.0 + nrm(ks[12], (DEPTH, 2 * HEAD_DIM), 0.02)
    c_rpb = nrm(ks[13], (DEPTH, C_HEADS, RPB_ROWS, RPB_COLS), 0.02)
    w_gate = nrm(ks[14], (DEPTH, D_MODEL, D_FF), D_MODEL ** -0.5 * DEEPNORM_BETA)
    w_up = nrm(ks[15], (DEPTH, D_MODEL, D_FF), D_MODEL ** -0.5 * DEEPNORM_BETA)
    w_down = nrm(ks[16], (DEPTH, D_FF, D_MODEL), D_FF ** -0.5 * DEEPNORM_BETA)
    ln_g = 1.0 + nrm(ks[17], (DEPTH, 2, D_MODEL), 0.02)
    ln_b = nrm(ks[18], (DEPTH, 2, D_MODEL), 0.02)
    return {'x_prompt': x_prompt, 'x_sample': x_sample, 'w_in': w_in, 'w_out': w_out,
            'a_ln_g': a_ln_g, 'a_ln_b': a_ln_b, 'a_w_s': a_w_s, 'a_b_s': a_b_s,
            'b_lambda_q1': b_lambda_q1, 'b_lambda_k1': b_lambda_k1,
            'b_lambda_q2': b_lambda_q2, 'b_lambda_k2': b_lambda_k2,
            'b_subln_g': b_subln_g, 'c_rpb': c_rpb,
            'w_gate': w_gate, 'w_up': w_up, 'w_down': w_down,
            'ln_g': ln_g, 'ln_b': ln_b}


def reference(x_prompt, x_sample, w_in, w_out, a_ln_g, a_ln_b, a_w_s, a_b_s, b_lambda_q1, b_lambda_k1,
              b_lambda_q2, b_lambda_k2, b_subln_g, c_rpb, w_gate, w_up, w_down, ln_g, ln_b):
    y_prompt = trunk(x_prompt, w_in, w_out, a_ln_g, a_ln_b, a_w_s, a_b_s, b_lambda_q1, b_lambda_k1,
                     b_lambda_q2, b_lambda_k2, b_subln_g, c_rpb, w_gate, w_up, w_down, ln_g, ln_b)
    y_sample = trunk(x_sample, w_in, w_out, a_ln_g, a_ln_b, a_w_s, a_b_s, b_lambda_q1, b_lambda_k1,
                     b_lambda_q2, b_lambda_k2, b_subln_g, c_rpb, w_gate, w_up, w_down, ln_g, ln_b)
    return (y_prompt, y_sample)
```

```cpp
#include <hip/hip_runtime.h>
#include <hip/hip_cooperative_groups.h>
#include <cstdio>
#include <cstdint>
namespace cg = cooperative_groups;

__device__ __forceinline__ int fresh_tid() { int t = threadIdx.x; asm volatile("" : "+v"(t)); return t; }
namespace pg8 {
#define PG8_LAS __attribute__((address_space(3)))
typedef unsigned short bf16_t;
typedef short bf16x8 __attribute__((ext_vector_type(8)));
typedef float f32x4 __attribute__((ext_vector_type(4)));
typedef unsigned u32x4 __attribute__((ext_vector_type(4)));
constexpr int BM = 256, BK = 64, HALF = 128, HTB = HALF * BK * 2  , STAGE_BYTES = 8 * HTB, NXCD = 8, WGM = 8;

__host__ __device__ __forceinline__ int lds_byte(int r, int c) { const int st = (r >> 4) * 2 + (c >> 5), rr = r & 15, cc = c & 31, ob = rr * 64 + cc * 2; return st * 1024 + (ob ^ (((ob >> 9) & 1) << 5)); }
__host__ __device__ __forceinline__ void stage_rc(int b, int& R, int& C) { const int st = b / 1024, sb = b % 1024, swz = sb ^ (((sb >> 9) & 1) << 5); R = (st >> 1) * 16 + swz / 64; C = (st & 1) * 32 + (swz % 64) / 2; }
__host__ __device__ __forceinline__ int perm32(int rho) { const int n = rho >> 4, i = rho & 15; return 8 * (i >> 2) + 4 * n + (i & 3); }

struct Unit { int pm, pn; };
struct Gemm { const bf16_t* A; const bf16_t* Bt; int M, N, K; };

struct StaticOrder {
    int nM, nN, nwg, G, c;
    __host__ __device__ void init(int M, int N, int G_, int c_) { nM = M / BM; nN = N / BM; nwg = nM * nN; G = G_; c = c_; }
    __host__ __device__ bool next(int i, Unit& u) const {
        const long L = (long)i * G + c; if (L >= nwg) return false;
        int wgid = (int)L; { const int q = nwg / NXCD, r = nwg % NXCD, xcd = wgid % NXCD, off = wgid / NXCD; wgid = (xcd < r ? xcd * (q + 1) : r * (q + 1) + (xcd - r) * q) + off; }
        const int nig = WGM * nN, gid = wgid / nig, fm = gid * WGM, gsz = (nM - fm) < WGM ? (nM - fm) : WGM;
        u.pm = fm + ((wgid % nig) % gsz); u.pn = (wgid % nig) / gsz; return true;
    }
    __device__ __forceinline__ void a_ready(const Unit&) const {}
    __device__ __forceinline__ void done(const Unit&) const {}
};

__device__ __forceinline__ unsigned cvt_pk_bf16(float lo, float hi) { unsigned r; asm volatile("v_cvt_pk_bf16_f32 %0, %1, %2" : "=v"(r) : "v"(lo), "v"(hi)); return r; }
template <class Epi, class Sched, bool ALIGN_EPI = false, bool SP2 = false>
__device__ __forceinline__ void gemm_phase(PG8_LAS unsigned char* lds, const Gemm g, const Sched& S, const Epi& E) {
    const int tid = fresh_tid(), wid = __builtin_amdgcn_readfirstlane(tid >> 6), lane = tid & 63, wr = wid >> 2, wc = wid & 3, fr = lane & 15, fq = lane >> 4;
    const int K = g.K, nt = K / BK;
    unsigned voffA[2], voffB[2];
#pragma unroll
    for (int i = 0; i < 2; ++i) { int R, C; stage_rc(tid * 16 + i * 8192, R, C); const int Rb = Epi::PERM ? ((R & ~31) + perm32(R & 31)) : R;
        voffA[i] = (unsigned)(R * K + C) * 2u; voffB[i] = (unsigned)(Rb * K + C) * 2u; }
    const size_t kstep = (size_t)(BK * 2);
    const size_t hstep = (size_t)HALF * K * 2;
    const size_t tstep = 2 * hstep;
    const unsigned ldsw = (unsigned)wid * 1024u;
    const int aoff = lds_byte(wr * 64 + fr, fq * 8), boff = lds_byte(wc * 32 + fr, fq * 8);
#define PG8_SA(b, h) (((b) * 2 + (h)) * HTB)
#define PG8_SB(b, h) ((4 + (b) * 2 + (h)) * HTB)
#define PG8_STAGE(bufoff, gbase, voff) do { _Pragma("unroll") for (int _i = 0; _i < 2; ++_i) \
        __builtin_amdgcn_global_load_lds((const unsigned*)((const char*)(gbase) + (voff)[_i]), (PG8_LAS unsigned*)(lds + (bufoff) + ldsw + _i * 8192), 16, 0, 0); } while (0)
#define PG8_LDA(dst, b, h) do { _Pragma("unroll") for (int m = 0; m < 4; ++m) _Pragma("unroll") for (int k = 0; k < 2; ++k) dst[m][k] = *(const PG8_LAS bf16x8*)(lds + PG8_SA(b, h) + aoff + m * 2048 + k * 1024); } while (0)
#define PG8_LDB(dst, b, h) do { _Pragma("unroll") for (int n = 0; n < 2; ++n) _Pragma("unroll") for (int k = 0; k < 2; ++k) dst[n][k] = *(const PG8_LAS bf16x8*)(lds + PG8_SB(b, h) + boff + n * 2048 + k * 1024); } while (0)
#define PG8_MMA(ai, bj, At, Bt) do { __builtin_amdgcn_s_setprio(1); _Pragma("unroll") for (int m = 0; m < 4; ++m) _Pragma("unroll") for (int n = 0; n < 2; ++n) _Pragma("unroll") for (int k = 0; k < 2; ++k) \
        acc[ai][bj][m][n] = __builtin_amdgcn_mfma_f32_16x16x32_bf16(Bt[n][k], At[m][k], acc[ai][bj][m][n], 0, 0, 0); __builtin_amdgcn_s_setprio(0); } while (0)
#define PG8_WAIT_V(n) asm volatile("s_waitcnt vmcnt(" #n ")" ::: "memory")
#define PG8_WAIT_L(n) asm volatile("s_waitcnt lgkmcnt(" #n ")" ::: "memory")
#define PG8_BAR __builtin_amdgcn_s_barrier()
#define PG8_SCHED __builtin_amdgcn_sched_barrier(0)
    Unit cur, nxt; int ui = 0;
    if (!S.next(0, cur)) return;
    f32x4 acc[2][2][4][2];
#pragma unroll
    for (int a = 0; a < 2; ++a)
#pragma unroll
        for (int b = 0; b < 2; ++b)
#pragma unroll
            for (int m = 0; m < 4; ++m)
#pragma unroll
                for (int n = 0; n < 2; ++n) acc[a][b][m][n] = (f32x4){0.f, 0.f, 0.f, 0.f};
    bf16x8 At[4][2], B0[2][2], B1[2][2];
    const char* cA = (const char*)g.A + (size_t)cur.pm * tstep; const char* cB = (const char*)g.Bt + (size_t)cur.pn * tstep;
    S.a_ready(cur);
    if constexpr (SP2) {
        PG8_STAGE(PG8_SB(0, 0), cB, voffB); PG8_STAGE(PG8_SB(0, 1), cB + hstep, voffB); PG8_STAGE(PG8_SA(0, 0), cA, voffA); PG8_STAGE(PG8_SA(0, 1), cA + hstep, voffA);
        if (wr == 1) PG8_BAR;
        PG8_WAIT_V(2); PG8_BAR;
        PG8_STAGE(PG8_SB(1, 0), cB + kstep, voffB); PG8_STAGE(PG8_SA(1, 0), cA + kstep, voffA); PG8_STAGE(PG8_SB(1, 1), cB + hstep + kstep, voffB);
        PG8_WAIT_V(6); PG8_BAR;
    } else {
        PG8_STAGE(PG8_SB(0, 0), cB, voffB); PG8_STAGE(PG8_SA(0, 0), cA, voffA); PG8_STAGE(PG8_SB(0, 1), cB + hstep, voffB); PG8_STAGE(PG8_SA(0, 1), cA + hstep, voffA);
        if (wr == 1) PG8_BAR;
        PG8_WAIT_V(4); PG8_BAR;
        PG8_STAGE(PG8_SB(1, 0), cB + kstep, voffB); PG8_STAGE(PG8_SA(1, 0), cA + kstep, voffA); PG8_STAGE(PG8_SB(1, 1), cB + hstep + kstep, voffB);
        PG8_WAIT_V(6); PG8_BAR;
    }
    for (;;) {
        const bool has_next = S.next(ui + 1, nxt);
        const char* nA = has_next ? (const char*)g.A + (size_t)nxt.pm * tstep : cA; const char* nB = has_next ? (const char*)g.Bt + (size_t)nxt.pn * tstep : cB;
        for (int t = 0; t < nt; t += 2) {
            const bool last = (t == nt - 2);
            const char* a1 = cA + (size_t)(t + 1) * kstep;
            const char* a2 = last ? nA : cA + (size_t)(t + 2) * kstep; const char* b2 = last ? nB : cB + (size_t)(t + 2) * kstep;
            const char* a3 = a2 + kstep; const char* b3 = b2 + kstep;
            if (last && has_next) S.a_ready(nxt);
            if constexpr (SP2) {
            PG8_LDB(B0, 0, 0); PG8_LDB(B1, 0, 1); PG8_SCHED; PG8_LDA(At, 0, 0); PG8_STAGE(PG8_SA(1, 1), a1 + hstep, voffA);
            PG8_WAIT_V(8); PG8_WAIT_L(0); PG8_BAR; PG8_MMA(0, 0, At, B0); PG8_MMA(0, 1, At, B1); PG8_BAR; PG8_SCHED;
            PG8_LDA(At, 0, 1); PG8_STAGE(PG8_SB(0, 0), b2, voffB); PG8_STAGE(PG8_SB(0, 1), b2 + hstep, voffB); PG8_STAGE(PG8_SA(0, 0), a2, voffA);
            PG8_WAIT_V(8); PG8_WAIT_L(0); PG8_BAR; PG8_MMA(1, 0, At, B0); PG8_MMA(1, 1, At, B1); PG8_BAR; PG8_SCHED;
            PG8_LDB(B0, 1, 0); PG8_LDB(B1, 1, 1); PG8_SCHED; PG8_LDA(At, 1, 0); PG8_STAGE(PG8_SA(0, 1), a2 + hstep, voffA);
            PG8_WAIT_V(8); PG8_WAIT_L(0); PG8_BAR; PG8_MMA(0, 0, At, B0); PG8_MMA(0, 1, At, B1); PG8_BAR; PG8_SCHED;
            PG8_LDA(At, 1, 1); PG8_STAGE(PG8_SB(1, 0), b3, voffB); PG8_STAGE(PG8_SB(1, 1), b3 + hstep, voffB); PG8_STAGE(PG8_SA(1, 0), a3, voffA);
            PG8_WAIT_V(8); PG8_WAIT_L(0); PG8_BAR; PG8_MMA(1, 0, At, B0); PG8_MMA(1, 1, At, B1); PG8_BAR; PG8_SCHED;
            } else {
            PG8_LDB(B0, 0, 0); PG8_SCHED; PG8_LDA(At, 0, 0); PG8_STAGE(PG8_SA(1, 1), a1 + hstep, voffA);
            PG8_WAIT_L(8); PG8_BAR; PG8_WAIT_L(0); PG8_MMA(0, 0, At, B0); PG8_BAR; PG8_SCHED;
            PG8_LDB(B1, 0, 1); PG8_STAGE(PG8_SB(0, 0), b2, voffB);
            PG8_BAR; PG8_WAIT_L(0); PG8_MMA(0, 1, At, B1); PG8_BAR;
            PG8_LDA(At, 0, 1); PG8_STAGE(PG8_SA(0, 0), a2, voffA);
            PG8_BAR; PG8_WAIT_L(0); PG8_MMA(1, 0, At, B0); PG8_BAR; PG8_SCHED;
            PG8_STAGE(PG8_SB(0, 1), b2 + hstep, voffB);
            PG8_WAIT_V(6); PG8_BAR; PG8_MMA(1, 1, At, B1); PG8_BAR;
            PG8_LDB(B0, 1, 0); PG8_SCHED; PG8_LDA(At, 1, 0); PG8_STAGE(PG8_SA(0, 1), a2 + hstep, voffA);
            PG8_WAIT_L(8); PG8_BAR; PG8_WAIT_L(0); PG8_MMA(0, 0, At, B0); PG8_BAR; PG8_SCHED;
            PG8_LDB(B1, 1, 1); PG8_STAGE(PG8_SB(1, 0), b3, voffB);
            PG8_BAR; PG8_WAIT_L(0); PG8_MMA(0, 1, At, B1); PG8_BAR;
            PG8_LDA(At, 1, 1); PG8_STAGE(PG8_SA(1, 0), a3, voffA);
            PG8_BAR; PG8_WAIT_L(0); PG8_MMA(1, 0, At, B0); PG8_BAR; PG8_SCHED;
            PG8_STAGE(PG8_SB(1, 1), b3 + hstep, voffB);
            PG8_WAIT_V(6); PG8_BAR; PG8_MMA(1, 1, At, B1); PG8_BAR;
            }
        }
        if constexpr (ALIGN_EPI) { if (wr == 0) PG8_BAR; }
        if constexpr (!Epi::AFTER_DRAIN) { E(acc, cur, wr, wc, fr, fq); S.done(cur); }
        if (!has_next) break;
#pragma unroll
        for (int a = 0; a < 2; ++a)
#pragma unroll
            for (int b = 0; b < 2; ++b)
#pragma unroll
                for (int m = 0; m < 4; ++m)
#pragma unroll
                    for (int n = 0; n < 2; ++n) acc[a][b][m][n] = (f32x4){0.f, 0.f, 0.f, 0.f};
        cur = nxt; cA = nA; cB = nB; ++ui;
        if constexpr (ALIGN_EPI) { if (wr == 1) PG8_BAR; }
    }
    PG8_WAIT_V(0);
    if constexpr (!ALIGN_EPI) { if (wr == 0) PG8_BAR; }
    PG8_BAR;
    if constexpr (Epi::AFTER_DRAIN) { E.fused(acc, cur, wr, wc, fr, fq, lds, wid, lane); S.done(cur); }
#undef PG8_SA
#undef PG8_SB
#undef PG8_STAGE
#undef PG8_LDA
#undef PG8_LDB
#undef PG8_MMA
#undef PG8_WAIT_V
#undef PG8_WAIT_L
#undef PG8_BAR
#undef PG8_SCHED
}
}

#define LAS __attribute__((address_space(3)))
typedef pg8::bf16_t bf16_t;
typedef pg8::bf16x8 bf16x8;
typedef pg8::f32x4 f32x4;
typedef pg8::u32x4 u32x4;
typedef float f32x16 __attribute__((ext_vector_type(16)));
typedef unsigned u32x2 __attribute__((ext_vector_type(2)));

constexpr int T_TOK = 81920, T_PROMPT = 16384, DM = 1024, INW = 2816, FFW = 2816, NLAYER = 2;
constexpr int S_PROMPT = 2048, S_SAMPLE = 4096;
constexpr float LN_EPS = 1e-5f, ALPHA = 1.4142135623730951f, LOG2E = 1.4426950408889634f;
constexpr float QSCALE = 0.125f * LOG2E;
constexpr size_t MiB = 1u << 20;
constexpr size_t WS_WIN = 0, WS_WOUT = 11 * MiB, WS_WGU = 15 * MiB, WS_WD = 37 * MiB, WS_WSB = 48 * MiB;
constexpr size_t WS_XB = 64 * MiB, WS_MIX = 224 * MiB, WS_H = 384 * MiB, WS_END = 824 * MiB;
constexpr int LDS_BYTES = 147456;

struct Args {
    const float* in[19];
    float* out;
    unsigned char* ws;
};

__device__ __forceinline__ unsigned cvtpk(float lo, float hi) { return pg8::cvt_pk_bf16(lo, hi); }
__device__ __forceinline__ float bf2f(unsigned short h) { return __uint_as_float(((unsigned)h) << 16); }
__device__ __forceinline__ float bflo(unsigned w) { return __uint_as_float(w << 16); }
__device__ __forceinline__ float bfhi(unsigned w) { return __uint_as_float(w & 0xffff0000u); }
__device__ __forceinline__ float fast_exp2(float x) { return __builtin_amdgcn_exp2f(x); }
__device__ __forceinline__ float fast_rcp(float x) { return __builtin_amdgcn_rcpf(x); }
__device__ __forceinline__ float gelu_tanh(float x) {
    const float u = x * (0.7978845608028654f + 0.035677408136300125f * x * x);
    const float e = fast_exp2(-2.0f * LOG2E * u);
    return x * fast_rcp(1.0f + e);
}
__device__ __forceinline__ float silu_f(float x) { return x * fast_rcp(1.0f + fast_exp2(-LOG2E * x)); }
__device__ __forceinline__ float swap_max(float v) {
    auto rr = __builtin_amdgcn_permlane32_swap(__float_as_uint(v), __float_as_uint(v), false, false);
    return fmaxf(__uint_as_float(rr[0]), __uint_as_float(rr[1]));
}
__device__ __forceinline__ float swap_sum(float v) {
    auto rr = __builtin_amdgcn_permlane32_swap(__float_as_uint(v), __float_as_uint(v), false, false);
    return __uint_as_float(rr[0]) + __uint_as_float(rr[1]);
}
__device__ __forceinline__ float wave_sum(float v) {
#pragma unroll
    for (int o = 1; o < 64; o <<= 1) v += __shfl_xor(v, o);
    return v;
}

struct EpiIn {
    static constexpr bool PERM = true, AFTER_DRAIN = false;
    bf16_t* O;
    __device__ __forceinline__ void operator()(const f32x4 (&acc)[2][2][4][2], const pg8::Unit& u, int wr, int wc, int fr, int fq) const {
        const int row0 = u.pm * 256 + wr * 64 + fr, col0 = u.pn * 256 + wc * 32 + 8 * fq;
        const bool dog = u.pn < 2;
        const float sc = (u.pn == 2 || u.pn == 3 || u.pn == 8) ? QSCALE : 1.0f;
#pragma unroll
        for (int ai = 0; ai < 2; ++ai)
#pragma unroll
            for (int m = 0; m < 4; ++m) {
                bf16_t* rowp = O + (size_t)(row0 + ai * 128 + m * 16) * INW + col0;
#pragma unroll
                for (int bj = 0; bj < 2; ++bj) {
                    f32x4 v0 = acc[ai][bj][m][0], v1 = acc[ai][bj][m][1];
                    if (dog) {
#pragma unroll
                        for (int e = 0; e < 4; ++e) { v0[e] = gelu_tanh(v0[e]); v1[e] = gelu_tanh(v1[e]); }
                    }
                    v0 = v0 * sc; v1 = v1 * sc;
                    u32x4 w; w.x = cvtpk(v0[0], v0[1]); w.y = cvtpk(v0[2], v0[3]); w.z = cvtpk(v1[0], v1[1]); w.w = cvtpk(v1[2], v1[3]);
                    *(u32x4*)(rowp + bj * 128) = w;
                }
            }
    }
};
struct EpiGU {
    static constexpr bool PERM = true, AFTER_DRAIN = false;
    bf16_t* O;
    __device__ __forceinline__ void operator()(const f32x4 (&acc)[2][2][4][2], const pg8::Unit& u, int wr, int wc, int fr, int fq) const {
        const int row0 = u.pm * 256 + wr * 64 + fr, col0 = u.pn * 128 + wc * 32 + 8 * fq;
#pragma unroll
        for (int ai = 0; ai < 2; ++ai)
#pragma unroll
            for (int m = 0; m < 4; ++m) {
                bf16_t* rowp = O + (size_t)(row0 + ai * 128 + m * 16) * FFW + col0;
                f32x4 h0, h1;
#pragma unroll
                for (int e = 0; e < 4; ++e) { h0[e] = silu_f(acc[ai][0][m][0][e]) * acc[ai][1][m][0][e]; h1[e] = silu_f(acc[ai][0][m][1][e]) * acc[ai][1][m][1][e]; }
                u32x4 w; w.x = cvtpk(h0[0], h0[1]); w.y = cvtpk(h0[2], h0[3]); w.z = cvtpk(h1[0], h1[1]); w.w = cvtpk(h1[2], h1[3]);
                *(u32x4*)rowp = w;
            }
    }
};
struct EpiRes {
    static constexpr bool PERM = false, AFTER_DRAIN = false;
    float* X;
    __device__ __forceinline__ void operator()(const f32x4 (&acc)[2][2][4][2], const pg8::Unit& u, int wr, int wc, int fr, int fq) const {
        float* base = X + (size_t)(u.pm * 256 + wr * 64 + fr) * DM + u.pn * 256 + wc * 32 + 4 * fq;
#pragma unroll
        for (int ai = 0; ai < 2; ++ai)
#pragma unroll
            for (int m = 0; m < 4; ++m) {
                float* p = base + (size_t)(ai * 128 + m * 16) * DM;
#pragma unroll
                for (int bj = 0; bj < 2; ++bj)
#pragma unroll
                    for (int n = 0; n < 2; ++n) {
                        const f32x4 s = *(const f32x4*)(p + bj * 128 + n * 16);
                        *(f32x4*)(p + bj * 128 + n * 16) = s * ALPHA + acc[ai][bj][m][n];
                    }
                asm volatile("" ::: "memory");
            }
    }
};

__device__ __forceinline__ void transpose_item(const float* W, int K, int N, bf16_t* WT, int mode, LAS float* scr, int item, int lane) {
    const int nblk = N / 32, kb = item / nblk, nb = item % nblk, k0 = 64 * kb, n0 = 32 * nb;
    const int rowbase = (mode == 0) ? n0 : (256 * (n0 / 128) + (n0 % 128) + (mode == 2 ? 128 : 0));
#pragma unroll 8
    for (int i = 0; i < 32; ++i) { const int kk = 2 * i + (lane >> 5); scr[kk * 33 + (lane & 31)] = W[(size_t)(k0 + kk) * N + n0 + (lane & 31)]; }
    asm volatile("s_waitcnt lgkmcnt(0)" ::: "memory");
    const int c = lane & 7;
#pragma unroll
    for (int j = 0; j < 4; ++j) {
        const int n = (lane >> 3) + 8 * j; const LAS float* s = scr + (8 * c) * 33 + n;
        u32x4 o; o.x = cvtpk(s[0 * 33], s[1 * 33]); o.y = cvtpk(s[2 * 33], s[3 * 33]); o.z = cvtpk(s[4 * 33], s[5 * 33]); o.w = cvtpk(s[6 * 33], s[7 * 33]);
        *(u32x4*)(WT + (size_t)(rowbase + n) * K + k0 + 8 * c) = o;
    }
    asm volatile("s_waitcnt lgkmcnt(0)" ::: "memory");
}

__device__ __forceinline__ void prologue(const Args& a, LAS unsigned char* lds) {
    const int tid = fresh_tid(), lane = tid & 63, wave = tid >> 6;
    const int G = gridDim.x, gw = blockIdx.x * 8 + wave, NGW = G * 8;
    LAS float* scr = (LAS float*)(lds + wave * 16384);
    constexpr int I_IN = 16 * 88, I_OUT = 16 * 32, I_G = 16 * 88, I_D = 44 * 32, I_L = I_IN + I_OUT + 2 * I_G + I_D;
    unsigned char* ws = a.ws;
    for (int it = gw; it < NLAYER * I_L; it += NGW) {
        const int l = it / I_L; int r = it % I_L;
        if (r < I_IN) { transpose_item(a.in[2] + (size_t)l * DM * INW, DM, INW, (bf16_t*)(ws + WS_WIN) + (size_t)l * INW * DM, 0, scr, r, lane); continue; } r -= I_IN;
        if (r < I_OUT) { transpose_item(a.in[3] + (size_t)l * DM * DM, DM, DM, (bf16_t*)(ws + WS_WOUT) + (size_t)l * DM * DM, 0, scr, r, lane); continue; } r -= I_OUT;
        if (r < I_G) { transpose_item(a.in[14] + (size_t)l * DM * FFW, DM, FFW, (bf16_t*)(ws + WS_WGU) + (size_t)l * 2 * FFW * DM, 1, scr, r, lane); continue; } r -= I_G;
        if (r < I_G) { transpose_item(a.in[15] + (size_t)l * DM * FFW, DM, FFW, (bf16_t*)(ws + WS_WGU) + (size_t)l * 2 * FFW * DM, 2, scr, r, lane); continue; } r -= I_G;
        transpose_item(a.in[16] + (size_t)l * FFW * DM, FFW, DM, (bf16_t*)(ws + WS_WD) + (size_t)l * DM * FFW, 0, scr, r, lane);
    }
    const int gt = blockIdx.x * 512 + tid, NGT = G * 512;
    for (int i = gt; i < 131072 / 4; i += NGT) {
        const f32x4 v = *(const f32x4*)(a.in[6] + (size_t)i * 4);
        u32x2 o; o.x = cvtpk(v[0], v[1]); o.y = cvtpk(v[2], v[3]);
        *(u32x2*)((bf16_t*)(ws + WS_WSB) + (size_t)i * 4) = o;
    }
    bf16_t* XB = (bf16_t*)(ws + WS_XB);
    for (int i = gt; i < T_TOK * DM / 8; i += NGT) {
        const size_t e = (size_t)i * 8;
        const float* src = (e < (size_t)T_PROMPT * DM) ? (a.in[0] + e) : (a.in[1] + (e - (size_t)T_PROMPT * DM));
        const f32x4 v0 = *(const f32x4*)src, v1 = *(const f32x4*)(src + 4);
        u32x4 o; o.x = cvtpk(v0[0], v0[1]); o.y = cvtpk(v0[2], v0[3]); o.z = cvtpk(v1[0], v1[1]); o.w = cvtpk(v1[2], v1[3]);
        *(u32x4*)(XB + e) = o;
        *(f32x4*)(a.out + e) = v0; *(f32x4*)(a.out + e + 4) = v1;
    }
}

__device__ __forceinline__ void ln_phase(float* X, bf16_t* XB, const float* g, const float* b, bool write_b) {
    const int tid = fresh_tid(), lane = tid & 63, wave = tid >> 6;
    const int gw = blockIdx.x * 8 + wave, NGW = gridDim.x * 8;
    f32x4 gv[4], bv[4];
#pragma unroll
    for (int j = 0; j < 4; ++j) { gv[j] = *(const f32x4*)(g + 4 * lane + 256 * j); bv[j] = *(const f32x4*)(b + 4 * lane + 256 * j); }
    for (int row = gw; row < T_TOK; row += NGW) {
        float* xr = X + (size_t)row * DM + 4 * lane;
        f32x4 v[4]; float s = 0.f;
#pragma unroll
        for (int j = 0; j < 4; ++j) { v[j] = *(const f32x4*)(xr + 256 * j); s += (v[j][0] + v[j][1]) + (v[j][2] + v[j][3]); }
        const float mean = wave_sum(s) * (1.0f / DM); float s2 = 0.f;
#pragma unroll
        for (int j = 0; j < 4; ++j) { v[j] = v[j] - mean; s2 += (v[j][0] * v[j][0] + v[j][1] * v[j][1]) + (v[j][2] * v[j][2] + v[j][3] * v[j][3]); }
        const float rstd = 1.0f / sqrtf(wave_sum(s2) * (1.0f / DM) + LN_EPS);
#pragma unroll
        for (int j = 0; j < 4; ++j) {
            const f32x4 o = v[j] * rstd * gv[j] + bv[j];
            *(f32x4*)(xr + 256 * j) = o;
            if (write_b) { u32x2 w; w.x = cvtpk(o[0], o[1]); w.y = cvtpk(o[2], o[3]); *(u32x2*)(XB + (size_t)row * DM + 4 * lane + 256 * j) = w; }
        }
    }
}

#define MFMA32(a, b, c) __builtin_amdgcn_mfma_f32_32x32x16_bf16((a), (b), (c), 0, 0, 0)
#define MFMA16(a, b, c) __builtin_amdgcn_mfma_f32_16x16x32_bf16((a), (b), (c), 0, 0, 0)

constexpr int SG_P = 272;
__device__ __forceinline__ void sgu_unit(LAS unsigned char* lds, const bf16_t* H, bf16_t* MIX, int chunk, const float* lng, const float* lnb, const bf16_t* wsb, const float* bs) {
    const int tid = fresh_tid(), lane = tid & 63, wave = tid >> 6;
    const int t0 = chunk * 128;
    __syncthreads();
    {
        const int s = tid >> 2, q = tid & 3;
        const bf16_t* src = H + (size_t)(t0 + s) * INW + 256 + 64 * q;
        u32x4 raw[8]; float sum = 0.f;
#pragma unroll
        for (int i = 0; i < 8; ++i) { raw[i] = *(const u32x4*)(src + 8 * i);
#pragma unroll
            for (int e = 0; e < 4; ++e) sum += bflo(raw[i][e]) + bfhi(raw[i][e]); }
        sum += __shfl_xor(sum, 1); sum += __shfl_xor(sum, 2);
        const float mean = sum * (1.0f / 256.0f); float sq = 0.f;
#pragma unroll
        for (int i = 0; i < 8; ++i)
#pragma unroll
            for (int e = 0; e < 4; ++e) { const float a = bflo(raw[i][e]) - mean, b = bfhi(raw[i][e]) - mean; sq += a * a + b * b; }
        sq += __shfl_xor(sq, 1); sq += __shfl_xor(sq, 2);
        const float rstd = 1.0f / sqrtf(sq * (1.0f / 256.0f) + LN_EPS);
#pragma unroll
        for (int i = 0; i < 8; ++i)
#pragma unroll
            for (int e = 0; e < 4; ++e) {
                const int ch = 64 * q + 8 * i + 2 * e;
                const float a = (bflo(raw[i][e]) - mean) * rstd * lng[ch] + lnb[ch];
                const float b = (bfhi(raw[i][e]) - mean) * rstd * lng[ch + 1] + lnb[ch + 1];
                const unsigned w = cvtpk(a, b);
                *(LAS unsigned short*)(lds + ch * SG_P + s * 2) = (unsigned short)(w & 0xffffu);
                *(LAS unsigned short*)(lds + (ch + 1) * SG_P + s * 2) = (unsigned short)(w >> 16);
            }
    }
    __syncthreads();
    {
        const int g = wave >> 1, th = wave & 1, fr = lane & 15, fq = lane >> 4;
        f32x4 acc[4][4];
#pragma unroll
        for (int ct = 0; ct < 4; ++ct)
#pragma unroll
            for (int tt = 0; tt < 4; ++tt) acc[ct][tt] = (f32x4){0.f, 0.f, 0.f, 0.f};
        const bf16_t* wg = wsb + (size_t)g * 128 * 128;
#pragma unroll
        for (int ks = 0; ks < 4; ++ks) {
            bf16x8 xf[4], yf[4];
#pragma unroll
            for (int ct = 0; ct < 4; ++ct) xf[ct] = *(const LAS bf16x8*)(lds + (g * 64 + 16 * ct + fr) * SG_P + (32 * ks + 8 * fq) * 2);
#pragma unroll
            for (int tt = 0; tt < 4; ++tt) yf[tt] = *(const bf16x8*)(wg + (size_t)(64 * th + 16 * tt + fr) * 128 + 32 * ks + 8 * fq);
#pragma unroll
            for (int ct = 0; ct < 4; ++ct)
#pragma unroll
                for (int tt = 0; tt < 4; ++tt) acc[ct][tt] = MFMA16(xf[ct], yf[tt], acc[ct][tt]);
        }
#pragma unroll
        for (int tt = 0; tt < 4; ++tt) {
            const int t = 64 * th + 16 * tt + fr;
            const float bias = bs[g * 128 + t];
#pragma unroll
            for (int ct = 0; ct < 4; ++ct) {
                const int c = g * 64 + 16 * ct + 4 * fq;
                const u32x2 uu = *(const u32x2*)(H + (size_t)(t0 + t) * INW + c);
                const float o0 = bflo(uu.x) * (acc[ct][tt][0] + bias), o1 = bfhi(uu.x) * (acc[ct][tt][1] + bias);
                const float o2 = bflo(uu.y) * (acc[ct][tt][2] + bias), o3 = bfhi(uu.y) * (acc[ct][tt][3] + bias);
                u32x2 w; w.x = cvtpk(o0, o1); w.y = cvtpk(o2, o3);
                *(u32x2*)(MIX + (size_t)(t0 + t) * DM + c) = w;
            }
        }
    }
}

constexpr int KP = 272, VP = 144, ATT_V_OFF = 64 * KP, ATT_Q_OFF = ATT_V_OFF + 128 * VP;
__device__ __forceinline__ int perm16(int x) { return (x & 3) | ((x & 4) << 1) | ((x & 8) >> 1); }
__device__ __forceinline__ void dattn_unit(LAS unsigned char* lds, const bf16_t* H, bf16_t* MIX, int tok0, int S, int h, int qb, float lam, float slope2,
                                           const float* subg, float outscale) {
    const int tid = fresh_tid(), lane = tid & 63, wave = tid >> 6, l32 = lane & 31, hi = lane >> 5;
    const int q0 = qb * 256 + wave * 32;
    LAS unsigned char* qlds = lds + ATT_Q_OFF + wave * (32 * KP) + l32 * KP + hi * 16;
    {
        const bf16_t* qsrc = H + (size_t)(tok0 + q0) * INW + 512 + h * 128;
#pragma unroll
        for (int i = 0; i < 8; ++i) {
            const int ch = lane + 64 * i, row = ch >> 4, part = ch & 15;
            *(LAS u32x4*)(lds + ATT_Q_OFF + wave * (32 * KP) + row * KP + part * 16) = *(const u32x4*)(qsrc + (size_t)row * INW + part * 8);
        }
    }
    f32x16 O[2][4];
#pragma unroll
    for (int c = 0; c < 2; ++c)
#pragma unroll
        for (int et = 0; et < 4; ++et)
#pragma unroll
            for (int j = 0; j < 16; ++j) O[c][et][j] = 0.f;
    float mrun[2] = {-1e30f, -1e30f}, lrun[2] = {0.f, 0.f};
    const int kkey0 = tid >> 4, kpart = tid & 15;
    const int vkey = lane, vec0 = wave;
    const bf16_t* kg = H + (size_t)(tok0 + kkey0) * INW + 1024 + h * 128 + kpart * 8;
    const bf16_t* vg = H + (size_t)(tok0 + vkey) * INW + 1536 + h * 128 + vec0 * 8;
    const int vpos = (vkey & ~15) | perm16(vkey & 15);
    u32x4 kr0, kr1, vr0, vr1;
    kr0 = *(const u32x4*)kg; kr1 = *(const u32x4*)(kg + (size_t)32 * INW);
    vr0 = *(const u32x4*)vg; vr1 = *(const u32x4*)(vg + 64);
    const int nt = S / 64;
    for (int t = 0; t < nt; ++t) {
        __syncthreads();
        *(LAS u32x4*)(lds + kkey0 * KP + kpart * 16) = kr0;
        *(LAS u32x4*)(lds + (kkey0 + 32) * KP + kpart * 16) = kr1;
#pragma unroll
        for (int i = 0; i < 4; ++i) {
            *(LAS unsigned short*)(lds + ATT_V_OFF + (vec0 * 8 + 2 * i) * VP + vpos * 2) = (unsigned short)(vr0[i] & 0xffffu);
            *(LAS unsigned short*)(lds + ATT_V_OFF + (vec0 * 8 + 2 * i + 1) * VP + vpos * 2) = (unsigned short)(vr0[i] >> 16);
            *(LAS unsigned short*)(lds + ATT_V_OFF + (vec0 * 8 + 64 + 2 * i) * VP + vpos * 2) = (unsigned short)(vr1[i] & 0xffffu);
            *(LAS unsigned short*)(lds + ATT_V_OFF + (vec0 * 8 + 64 + 2 * i + 1) * VP + vpos * 2) = (unsigned short)(vr1[i] >> 16);
        }
        __syncthreads();
        if (t + 1 < nt) {
            const size_t adv = (size_t)(t + 1) * 64 * INW;
            kr0 = *(const u32x4*)(kg + adv); kr1 = *(const u32x4*)(kg + adv + (size_t)32 * INW);
            vr0 = *(const u32x4*)(vg + adv); vr1 = *(const u32x4*)(vg + adv + 64);
        }
        const int k0 = t * 64;
        const float dq = (float)(q0 + l32 - k0 - 4 * hi);
#pragma unroll
        for (int c = 0; c < 2; ++c) {
#pragma unroll
            for (int kt = 0; kt < 2; ++kt) {
                f32x16 sv;
#pragma unroll
                for (int j = 0; j < 16; ++j) sv[j] = -slope2 * fabsf(dq - (float)(32 * kt + (j & 3) + 8 * (j >> 2)));
#pragma unroll
                for (int s = 0; s < 4; ++s) {
                    const bf16x8 kf = *(const LAS bf16x8*)(lds + (32 * kt + l32) * KP + (c * 64 + s * 16 + hi * 8) * 2);
                    const bf16x8 qfr = *(const LAS bf16x8*)(qlds + (c * 64 + s * 16) * 2);
                    sv = MFMA32(kf, qfr, sv);
                }
                __builtin_amdgcn_sched_barrier(0);
                float mx = sv[0];
#pragma unroll
                for (int j = 1; j < 16; ++j) mx = fmaxf(mx, sv[j]);
                mx = swap_max(mx);
                if (__any(mx > mrun[c])) {
                    const float mn = fmaxf(mrun[c], mx);
                    const float alpha = fast_exp2(mrun[c] - mn);
                    mrun[c] = mn; lrun[c] *= alpha;
#pragma unroll
                    for (int et = 0; et < 4; ++et)
#pragma unroll
                        for (int j = 0; j < 16; ++j) O[c][et][j] *= alpha;
                }
                const float mcur = mrun[c];
                float ps = 0.f;
#pragma unroll
                for (int j = 0; j < 16; ++j) { sv[j] = fast_exp2(sv[j] - mcur); ps += sv[j]; }
                lrun[c] += ps;
                bf16x8 pf0, pf1;
                {
                    u32x4 w;
                    w.x = cvtpk(sv[0], sv[1]); w.y = cvtpk(sv[2], sv[3]); w.z = cvtpk(sv[4], sv[5]); w.w = cvtpk(sv[6], sv[7]); pf0 = __builtin_bit_cast(bf16x8, w);
                    w.x = cvtpk(sv[8], sv[9]); w.y = cvtpk(sv[10], sv[11]); w.z = cvtpk(sv[12], sv[13]); w.w = cvtpk(sv[14], sv[15]); pf1 = __builtin_bit_cast(bf16x8, w);
                }
                __builtin_amdgcn_sched_barrier(0);
#pragma unroll
                for (int et = 0; et < 4; ++et) {
                    const bf16x8 vf0 = *(const LAS bf16x8*)(lds + ATT_V_OFF + (32 * et + l32) * VP + (32 * kt + 8 * hi) * 2);
                    const bf16x8 vf1 = *(const LAS bf16x8*)(lds + ATT_V_OFF + (32 * et + l32) * VP + (32 * kt + 16 + 8 * hi) * 2);
                    O[c][et] = MFMA32(vf0, pf0, O[c][et]);
                    O[c][et] = MFMA32(vf1, pf1, O[c][et]);
                }
                __builtin_amdgcn_sched_barrier(0);
            }
        }
    }
    const float r0 = fast_rcp(swap_sum(lrun[0])), r1 = lam * fast_rcp(swap_sum(lrun[1]));
    float ss = 0.f;
#pragma unroll
    for (int et = 0; et < 4; ++et)
#pragma unroll
        for (int j = 0; j < 16; ++j) { const float o = O[0][et][j] * r0 - O[1][et][j] * r1; O[0][et][j] = o; ss += o * o; }
    ss = swap_sum(ss);
    const float rms = outscale / sqrtf(ss * (1.0f / 128.0f) + LN_EPS);
    bf16_t* orow = MIX + (size_t)(tok0 + q0 + l32) * DM + 256 + h * 128;
#pragma unroll
    for (int et = 0; et < 4; ++et)
#pragma unroll
        for (int jq = 0; jq < 4; ++jq) {
            const int e = 32 * et + 8 * jq + 4 * hi;
            const f32x4 gq = *(const f32x4*)(subg + e);
            u32x2 w; w.x = cvtpk(O[0][et][4 * jq] * rms * gq[0], O[0][et][4 * jq + 1] * rms * gq[1]);
            w.y = cvtpk(O[0][et][4 * jq + 2] * rms * gq[2], O[0][et][4 * jq + 3] * rms * gq[3]);
            *(u32x2*)(orow + e) = w;
        }
}

__device__ __forceinline__ void na_unit(const bf16_t* H, bf16_t* MIX, int tok0, int rows, int r, const float* rpb) {
    const int tid = fresh_tid(), lane = tid & 63, wave = tid >> 6, fr = lane & 15, fq = lane >> 4;
    const int h = wave >> 1;
    const int rs = min(max(r - 4, 0), rows - 8);
    for (int cgi = 0; cgi < 2; ++cgi) {
        const int cgp = 2 * (wave & 1) + cgi;
        const int kc0 = (cgp == 0) ? 0 : (cgp == 1) ? 8 : (cgp == 2) ? 24 : 32;
        const int col = 16 * cgp + fr;
        const int qtok = tok0 + r * 64 + col;
        bf16x8 qf[2];
#pragma unroll
        for (int ks = 0; ks < 2; ++ks) qf[ks] = *(const bf16x8*)(H + (size_t)qtok * INW + 2048 + h * 64 + ks * 32 + fq * 8);
        f32x4 sc[8][2];
#pragma unroll
        for (int i = 0; i < 8; ++i)
#pragma unroll
            for (int t = 0; t < 2; ++t) {
                const int ktok = tok0 + (rs + i) * 64 + kc0 + 16 * t + fr;
                const bf16_t* kp = H + (size_t)ktok * INW + 2304 + h * 64 + fq * 8;
                const bf16x8 k0 = *(const bf16x8*)kp, k1 = *(const bf16x8*)(kp + 32);
                f32x4 a = (f32x4){0.f, 0.f, 0.f, 0.f};
                a = MFMA16(k0, qf[0], a); a = MFMA16(k1, qf[1], a);
                sc[i][t] = a;
            }
        const int cs = min(max(col - 8, 0), 48);
        float mx = -1e30f;
#pragma unroll
        for (int i = 0; i < 8; ++i) {
            const int row_off = rs + i - r + 7;
#pragma unroll
            for (int t = 0; t < 2; ++t)
#pragma unroll
                for (int ii = 0; ii < 4; ++ii) {
                    const int kc = kc0 + 16 * t + 4 * fq + ii;
                    const bool valid = (kc >= cs) && (kc < cs + 16);
                    const int col_off = valid ? (kc - col + 15) : 0;
                    const float bias = rpb[(h * 15 + row_off) * 31 + col_off] * LOG2E;
                    const float v = valid ? (sc[i][t][ii] + bias) : -1e30f;
                    sc[i][t][ii] = v; mx = fmaxf(mx, v);
                }
        }
        mx = fmaxf(mx, __shfl_xor(mx, 16)); mx = fmaxf(mx, __shfl_xor(mx, 32));
        float sum = 0.f;
#pragma unroll
        for (int i = 0; i < 8; ++i)
#pragma unroll
            for (int t = 0; t < 2; ++t)
#pragma unroll
                for (int ii = 0; ii < 4; ++ii) { const float p = fast_exp2(sc[i][t][ii] - mx); sc[i][t][ii] = p; sum += p; }
        sum += __shfl_xor(sum, 16); sum += __shfl_xor(sum, 32);
        const float rinv = fast_rcp(sum);
        f32x4 o[4];
#pragma unroll
        for (int et = 0; et < 4; ++et) o[et] = (f32x4){0.f, 0.f, 0.f, 0.f};
#pragma unroll
        for (int i = 0; i < 8; ++i) {
            u32x4 w; w.x = cvtpk(sc[i][0][0], sc[i][0][1]); w.y = cvtpk(sc[i][0][2], sc[i][0][3]); w.z = cvtpk(sc[i][1][0], sc[i][1][1]); w.w = cvtpk(sc[i][1][2], sc[i][1][3]);
            const bf16x8 pf = __builtin_bit_cast(bf16x8, w);
            const bf16_t* vbase = H + (size_t)(tok0 + (rs + i) * 64 + kc0 + 4 * fq) * INW + 2560 + h * 64 + fr;
#pragma unroll
            for (int et = 0; et < 4; ++et) {
                bf16x8 vf;
#pragma unroll
                for (int ii = 0; ii < 4; ++ii) {
                    vf[ii] = (short)vbase[(size_t)ii * INW + 16 * et];
                    vf[4 + ii] = (short)vbase[(size_t)(16 + ii) * INW + 16 * et];
                }
                o[et] = MFMA16(vf, pf, o[et]);
            }
        }
        bf16_t* orow = MIX + (size_t)qtok * DM + 768 + h * 64 + 4 * fq;
#pragma unroll
        for (int et = 0; et < 4; ++et) {
            u32x2 w; w.x = cvtpk(o[et][0] * rinv, o[et][1] * rinv); w.y = cvtpk(o[et][2] * rinv, o[et][3] * rinv);
            *(u32x2*)(orow + 16 * et) = w;
        }
    }
}

__global__ void __launch_bounds__(512, 2) fwd_megakernel(Args a) {
    extern __shared__ __attribute__((aligned(16))) unsigned char lds_raw[];
    LAS unsigned char* lds = (LAS unsigned char*)lds_raw;
    cg::grid_group grid = cg::this_grid();
    const int G = gridDim.x, bx = blockIdx.x;
    unsigned char* ws = a.ws;
    bf16_t* XB = (bf16_t*)(ws + WS_XB); bf16_t* MIX = (bf16_t*)(ws + WS_MIX); bf16_t* Hb = (bf16_t*)(ws + WS_H);
    float* OUT = a.out;

    prologue(a, lds);
    grid.sync();

    for (int l = 0; l < NLAYER; ++l) {
        {
            pg8::Gemm g{XB, (const bf16_t*)(ws + WS_WIN) + (size_t)l * INW * DM, T_TOK, INW, DM};
            pg8::StaticOrder S; S.init(T_TOK, INW, G, bx);
            EpiIn E{Hb};
            pg8::gemm_phase<EpiIn, pg8::StaticOrder, true, true>(lds, g, S, E);
        }
        grid.sync();
        {
            const int lane = threadIdx.x & 63;
            const float lam_init = (l == 0) ? 0.2f : (0.8f - 0.6f * 0.7408182206817179f);
            const float s1 = wave_sum(a.in[8][l * 64 + lane] * a.in[9][l * 64 + lane]);
            const float s2 = wave_sum(a.in[10][l * 64 + lane] * a.in[11][l * 64 + lane]);
            const float lam = expf(s1) - expf(s2) + lam_init;
            const float* subg = a.in[12] + l * 128;
            const int x = bx & 7, m = bx >> 3;
            for (int u = bx; u < 1280; u += G) {
                int tok0, S, h, qb;
                if (u < 1024) { const int j = u >> 8, uu = u & 255, xx = uu & 7, mm = uu >> 3; const int bh = j * 16 + xx * 2 + (mm >> 4); qb = mm & 15; S = S_SAMPLE; tok0 = T_PROMPT + (bh >> 2) * S_SAMPLE; h = bh & 3; }
                else { const int uu = u - 1024, xx = uu & 7, mm = uu >> 3; const int bh = xx * 4 + (mm >> 3); qb = mm & 7; S = S_PROMPT; tok0 = (bh >> 2) * S_PROMPT; h = bh & 3; }
                const float slope2 = LOG2E * exp2f(-2.0f * (float)(h + 1));
                dattn_unit(lds, Hb, MIX, tok0, S, h, qb, lam, slope2, subg, 1.0f - lam_init);
            }
            for (int c = bx; c < T_TOK / 128; c += G)
                sgu_unit(lds, Hb, MIX, c, a.in[4] + l * 256, a.in[5] + l * 256, (const bf16_t*)(ws + WS_WSB) + (size_t)l * 4 * 128 * 128, a.in[7] + l * 512);
            const int nrows = T_TOK / 64;
            for (int k = bx; k < nrows; k += G) {
                int R = k;
                if (G == 256) R = x * 160 + m * 5 + (k >> 8);
                int tok0, rows, r;
                if (R < 256) { tok0 = (R >> 5) * S_PROMPT; rows = 32; r = R & 31; }
                else { const int Rp = R - 256; tok0 = T_PROMPT + (Rp >> 6) * S_SAMPLE; rows = 64; r = Rp & 63; }
                na_unit(Hb, MIX, tok0, rows, r, a.in[13] + l * 4 * 15 * 31);
            }
        }
        grid.sync();
        {
            pg8::Gemm g{MIX, (const bf16_t*)(ws + WS_WOUT) + (size_t)l * DM * DM, T_TOK, DM, DM};
            pg8::StaticOrder S; S.init(T_TOK, DM, G, bx);
            EpiRes E{OUT};
            pg8::gemm_phase<EpiRes, pg8::StaticOrder, true, true>(lds, g, S, E);
        }
        grid.sync();
        ln_phase(OUT, XB, a.in[17] + (l * 2 + 0) * DM, a.in[18] + (l * 2 + 0) * DM, true);
        grid.sync();
        {
            pg8::Gemm g{XB, (const bf16_t*)(ws + WS_WGU) + (size_t)l * 2 * FFW * DM, T_TOK, 2 * FFW, DM};
            pg8::StaticOrder S; S.init(T_TOK, 2 * FFW, G, bx);
            EpiGU E{Hb};
            pg8::gemm_phase<EpiGU, pg8::StaticOrder, true, true>(lds, g, S, E);
        }
        grid.sync();
        {
            pg8::Gemm g{Hb, (const bf16_t*)(ws + WS_WD) + (size_t)l * DM * FFW, T_TOK, DM, FFW};
            pg8::StaticOrder S; S.init(T_TOK, DM, G, bx);
            EpiRes E{OUT};
            pg8::gemm_phase<EpiRes, pg8::StaticOrder, true, true>(lds, g, S, E);
        }
        grid.sync();
        ln_phase(OUT, XB, a.in[17] + (l * 2 + 1) * DM, a.in[18] + (l * 2 + 1) * DM, l + 1 < NLAYER);
        if (l + 1 < NLAYER) grid.sync();
    }
}

extern "C" void kernel_launch(void* const* d_in, const int* in_sizes, int n_in, void* d_out, int out_size, void* d_ws, size_t ws_size, hipStream_t stream) {
    static int grid_blocks = 0;
    if (grid_blocks == 0) {
        if (n_in != 19 || ws_size < WS_END) { fprintf(stderr, "kernel_launch: unexpected n_in %d / ws_size %zu\n", n_in, ws_size); grid_blocks = -1; return; }
        int dev = 0, cus = 0, per_cu = 0;
        hipGetDevice(&dev);
        hipDeviceGetAttribute(&cus, hipDeviceAttributeMultiprocessorCount, dev);
        if (hipFuncSetAttribute((const void*)fwd_megakernel, hipFuncAttributeMaxDynamicSharedMemorySize, LDS_BYTES) != hipSuccess) fprintf(stderr, "kernel_launch: hipFuncSetAttribute failed\n");
        if (hipOccupancyMaxActiveBlocksPerMultiprocessor(&per_cu, (const void*)fwd_megakernel, 512, LDS_BYTES) != hipSuccess || per_cu < 1) { fprintf(stderr, "kernel_launch: occupancy query says %d\n", per_cu); per_cu = 1; }
        (void)hipGetLastError();
        grid_blocks = cus * per_cu;
    }
    if (grid_blocks < 0) return;
    Args a{};
    for (int i = 0; i < 19; ++i) a.in[i] = (const float*)d_in[i];
    a.out = (float*)d_out; a.ws = (unsigned char*)d_ws;
    void* args[] = {&a};
    hipError_t e = hipLaunchCooperativeKernel((const void*)fwd_megakernel, dim3(grid_blocks), dim3(512), args, LDS_BYTES, stream);
    if (e != hipSuccess) fprintf(stderr, "cooperative launch failed: %s (grid %d)\n", hipGetErrorString(e), grid_blocks);
}
```

```cpp
#include <hip/hip_runtime.h>
#include <hip/hip_cooperative_groups.h>
#include <cstdio>
#include <cstdint>
namespace cg = cooperative_groups;

__device__ __forceinline__ int fresh_tid() { int t = threadIdx.x; asm volatile("" : "+v"(t)); return t; }
namespace pg8 {
#define PG8_LAS __attribute__((address_space(3)))
typedef unsigned short bf16_t;
typedef short bf16x8 __attribute__((ext_vector_type(8)));
typedef float f32x4 __attribute__((ext_vector_type(4)));
typedef unsigned u32x4 __attribute__((ext_vector_type(4)));
constexpr int BM = 256, BK = 64, HALF = 128, HTB = HALF * BK * 2  , STAGE_BYTES = 8 * HTB, NXCD = 8, WGM = 8;

__host__ __device__ __forceinline__ int lds_byte(int r, int c) { const int st = (r >> 4) * 2 + (c >> 5), rr = r & 15, cc = c & 31, ob = rr * 64 + cc * 2; return st * 1024 + (ob ^ (((ob >> 9) & 1) << 5)); }
__host__ __device__ __forceinline__ void stage_rc(int b, int& R, int& C) { const int st = b / 1024, sb = b % 1024, swz = sb ^ (((sb >> 9) & 1) << 5); R = (st >> 1) * 16 + swz / 64; C = (st & 1) * 32 + (swz % 64) / 2; }
__host__ __device__ __forceinline__ int perm32(int rho) { const int n = rho >> 4, i = rho & 15; return 8 * (i >> 2) + 4 * n + (i & 3); }

struct Unit { int pm, pn; };
struct Gemm { const bf16_t* A; const bf16_t* Bt; int M, N, K; };

struct StaticOrder {
    int nM, nN, nwg, G, c;
    __host__ __device__ void init(int M, int N, int G_, int c_) { nM = M / BM; nN = N / BM; nwg = nM * nN; G = G_; c = c_; }
    __host__ __device__ bool next(int i, Unit& u) const {
        const long L = (long)i * G + c; if (L >= nwg) return false;
        int wgid = (int)L; { const int q = nwg / NXCD, r = nwg % NXCD, xcd = wgid % NXCD, off = wgid / NXCD; wgid = (xcd < r ? xcd * (q + 1) : r * (q + 1) + (xcd - r) * q) + off; }
        const int nig = WGM * nN, gid = wgid / nig, fm = gid * WGM, gsz = (nM - fm) < WGM ? (nM - fm) : WGM;
        u.pm = fm + ((wgid % nig) % gsz); u.pn = (wgid % nig) / gsz; return true;
    }
    __device__ __forceinline__ void a_ready(const Unit&) const {}
    __device__ __forceinline__ void done(const Unit&) const {}
};

__device__ __forceinline__ unsigned cvt_pk_bf16(float lo, float hi) { unsigned r; asm volatile("v_cvt_pk_bf16_f32 %0, %1, %2" : "=v"(r) : "v"(lo), "v"(hi)); return r; }
template <class Epi, class Sched, bool ALIGN_EPI = false, bool SP2 = false>
__device__ __forceinline__ void gemm_phase(PG8_LAS unsigned char* lds, const Gemm g, const Sched& S, const Epi& E) {
    const int tid = fresh_tid(), wid = __builtin_amdgcn_readfirstlane(tid >> 6), lane = tid & 63, wr = wid >> 2, wc = wid & 3, fr = lane & 15, fq = lane >> 4;
    const int K = g.K, nt = K / BK;
    unsigned voffA[2], voffB[2];
#pragma unroll
    for (int i = 0; i < 2; ++i) { int R, C; stage_rc(tid * 16 + i * 8192, R, C); const int Rb = Epi::PERM ? ((R & ~31) + perm32(R & 31)) : R;
        voffA[i] = (unsigned)(R * K + C) * 2u; voffB[i] = (unsigned)(Rb * K + C) * 2u; }
    const size_t kstep = (size_t)(BK * 2);
    const size_t hstep = (size_t)HALF * K * 2;
    const size_t tstep = 2 * hstep;
    const unsigned ldsw = (unsigned)wid * 1024u;
    const int aoff = lds_byte(wr * 64 + fr, fq * 8), boff = lds_byte(wc * 32 + fr, fq * 8);
#define PG8_SA(b, h) (((b) * 2 + (h)) * HTB)
#define PG8_SB(b, h) ((4 + (b) * 2 + (h)) * HTB)
#define PG8_STAGE(bufoff, gbase, voff) do { _Pragma("unroll") for (int _i = 0; _i < 2; ++_i) \
        __builtin_amdgcn_global_load_lds((const unsigned*)((const char*)(gbase) + (voff)[_i]), (PG8_LAS unsigned*)(lds + (bufoff) + ldsw + _i * 8192), 16, 0, 0); } while (0)
#define PG8_LDA(dst, b, h) do { _Pragma("unroll") for (int m = 0; m < 4; ++m) _Pragma("unroll") for (int k = 0; k < 2; ++k) dst[m][k] = *(const PG8_LAS bf16x8*)(lds + PG8_SA(b, h) + aoff + m * 2048 + k * 1024); } while (0)
#define PG8_LDB(dst, b, h) do { _Pragma("unroll") for (int n = 0; n < 2; ++n) _Pragma("unroll") for (int k = 0; k < 2; ++k) dst[n][k] = *(const PG8_LAS bf16x8*)(lds + PG8_SB(b, h) + boff + n * 2048 + k * 1024); } while (0)
#define PG8_MMA(ai, bj, At, Bt) do { __builtin_amdgcn_s_setprio(1); _Pragma("unroll") for (int m = 0; m < 4; ++m) _Pragma("unroll") for (int n = 0; n < 2; ++n) _Pragma("unroll") for (int k = 0; k < 2; ++k) \
        acc[ai][bj][m][n] = __builtin_amdgcn_mfma_f32_16x16x32_bf16(Bt[n][k], At[m][k], acc[ai][bj][m][n], 0, 0, 0); __builtin_amdgcn_s_setprio(0); } while (0)
#define PG8_WAIT_V(n) asm volatile("s_waitcnt vmcnt(" #n ")" ::: "memory")
#define PG8_WAIT_L(n) asm volatile("s_waitcnt lgkmcnt(" #n ")" ::: "memory")
#define PG8_BAR __builtin_amdgcn_s_barrier()
#define PG8_SCHED __builtin_amdgcn_sched_barrier(0)
    Unit cur, nxt; int ui = 0;
    if (!S.next(0, cur)) return;
    f32x4 acc[2][2][4][2];
#pragma unroll
    for (int a = 0; a < 2; ++a)
#pragma unroll
        for (int b = 0; b < 2; ++b)
#pragma unroll
            for (int m = 0; m < 4; ++m)
#pragma unroll
                for (int n = 0; n < 2; ++n) acc[a][b][m][n] = (f32x4){0.f, 0.f, 0.f, 0.f};
    bf16x8 At[4][2], B0[2][2], B1[2][2];
    const char* cA = (const char*)g.A + (size_t)cur.pm * tstep; const char* cB = (const char*)g.Bt + (size_t)cur.pn * tstep;
    S.a_ready(cur);
    if constexpr (SP2) {
        PG8_STAGE(PG8_SB(0, 0), cB, voffB); PG8_STAGE(PG8_SB(0, 1), cB + hstep, voffB); PG8_STAGE(PG8_SA(0, 0), cA, voffA); PG8_STAGE(PG8_SA(0, 1), cA + hstep, voffA);
        if (wr == 1) PG8_BAR;
        PG8_WAIT_V(2); PG8_BAR;
        PG8_STAGE(PG8_SB(1, 0), cB + kstep, voffB); PG8_STAGE(PG8_SA(1, 0), cA + kstep, voffA); PG8_STAGE(PG8_SB(1, 1), cB + hstep + kstep, voffB);
        PG8_WAIT_V(6); PG8_BAR;
    } else {
        PG8_STAGE(PG8_SB(0, 0), cB, voffB); PG8_STAGE(PG8_SA(0, 0), cA, voffA); PG8_STAGE(PG8_SB(0, 1), cB + hstep, voffB); PG8_STAGE(PG8_SA(0, 1), cA + hstep, voffA);
        if (wr == 1) PG8_BAR;
        PG8_WAIT_V(4); PG8_BAR;
        PG8_STAGE(PG8_SB(1, 0), cB + kstep, voffB); PG8_STAGE(PG8_SA(1, 0), cA + kstep, voffA); PG8_STAGE(PG8_SB(1, 1), cB + hstep + kstep, voffB);
        PG8_WAIT_V(6); PG8_BAR;
    }
    for (;;) {
        const bool has_next = S.next(ui + 1, nxt);
        const char* nA = has_next ? (const char*)g.A + (size_t)nxt.pm * tstep : cA; const char* nB = has_next ? (const char*)g.Bt + (size_t)nxt.pn * tstep : cB;
        for (int t = 0; t < nt; t += 2) {
            const bool last = (t == nt - 2);
            const char* a1 = cA + (size_t)(t + 1) * kstep;
            const char* a2 = last ? nA : cA + (size_t)(t + 2) * kstep; const char* b2 = last ? nB : cB + (size_t)(t + 2) * kstep;
            const char* a3 = a2 + kstep; const char* b3 = b2 + kstep;
            if (last && has_next) S.a_ready(nxt);
            if constexpr (SP2) {
            PG8_LDB(B0, 0, 0); PG8_LDB(B1, 0, 1); PG8_SCHED; PG8_LDA(At, 0, 0); PG8_STAGE(PG8_SA(1, 1), a1 + hstep, voffA);
            PG8_WAIT_V(8); PG8_WAIT_L(0); PG8_BAR; PG8_MMA(0, 0, At, B0); PG8_MMA(0, 1, At, B1); PG8_BAR; PG8_SCHED;
            PG8_LDA(At, 0, 1); PG8_STAGE(PG8_SB(0, 0), b2, voffB); PG8_STAGE(PG8_SB(0, 1), b2 + hstep, voffB); PG8_STAGE(PG8_SA(0, 0), a2, voffA);
            PG8_WAIT_V(8); PG8_WAIT_L(0); PG8_BAR; PG8_MMA(1, 0, At, B0); PG8_MMA(1, 1, At, B1); PG8_BAR; PG8_SCHED;
            PG8_LDB(B0, 1, 0); PG8_LDB(B1, 1, 1); PG8_SCHED; PG8_LDA(At, 1, 0); PG8_STAGE(PG8_SA(0, 1), a2 + hstep, voffA);
            PG8_WAIT_V(8); PG8_WAIT_L(0); PG8_BAR; PG8_MMA(0, 0, At, B0); PG8_MMA(0, 1, At, B1); PG8_BAR; PG8_SCHED;
            PG8_LDA(At, 1, 1); PG8_STAGE(PG8_SB(1, 0), b3, voffB); PG8_STAGE(PG8_SB(1, 1), b3 + hstep, voffB); PG8_STAGE(PG8_SA(1, 0), a3, voffA);
            PG8_WAIT_V(8); PG8_WAIT_L(0); PG8_BAR; PG8_MMA(1, 0, At, B0); PG8_MMA(1, 1, At, B1); PG8_BAR; PG8_SCHED;
            } else {
            PG8_LDB(B0, 0, 0); PG8_SCHED; PG8_LDA(At, 0, 0); PG8_STAGE(PG8_SA(1, 1), a1 + hstep, voffA);
            PG8_WAIT_L(8); PG8_BAR; PG8_WAIT_L(0); PG8_MMA(0, 0, At, B0); PG8_BAR; PG8_SCHED;
            PG8_LDB(B1, 0, 1); PG8_STAGE(PG8_SB(0, 0), b2, voffB);
            PG8_BAR; PG8_WAIT_L(0); PG8_MMA(0, 1, At, B1); PG8_BAR;
            PG8_LDA(At, 0, 1); PG8_STAGE(PG8_SA(0, 0), a2, voffA);
            PG8_BAR; PG8_WAIT_L(0); PG8_MMA(1, 0, At, B0); PG8_BAR; PG8_SCHED;
            PG8_STAGE(PG8_SB(0, 1), b2 + hstep, voffB);
            PG8_WAIT_V(6); PG8_BAR; PG8_MMA(1, 1, At, B1); PG8_BAR;
            PG8_LDB(B0, 1, 0); PG8_SCHED; PG8_LDA(At, 1, 0); PG8_STAGE(PG8_SA(0, 1), a2 + hstep, voffA);
            PG8_WAIT_L(8); PG8_BAR; PG8_WAIT_L(0); PG8_MMA(0, 0, At, B0); PG8_BAR; PG8_SCHED;
            PG8_LDB(B1, 1, 1); PG8_STAGE(PG8_SB(1, 0), b3, voffB);
            PG8_BAR; PG8_WAIT_L(0); PG8_MMA(0, 1, At, B1); PG8_BAR;
            PG8_LDA(At, 1, 1); PG8_STAGE(PG8_SA(1, 0), a3, voffA);
            PG8_BAR; PG8_WAIT_L(0); PG8_MMA(1, 0, At, B0); PG8_BAR; PG8_SCHED;
            PG8_STAGE(PG8_SB(1, 1), b3 + hstep, voffB);
            PG8_WAIT_V(6); PG8_BAR; PG8_MMA(1, 1, At, B1); PG8_BAR;
            }
        }
        if constexpr (ALIGN_EPI) { if (wr == 0) PG8_BAR; }
        if constexpr (!Epi::AFTER_DRAIN) { E(acc, cur, wr, wc, fr, fq); S.done(cur); }
        if (!has_next) break;
#pragma unroll
        for (int a = 0; a < 2; ++a)
#pragma unroll
            for (int b = 0; b < 2; ++b)
#pragma unroll
                for (int m = 0; m < 4; ++m)
#pragma unroll
                    for (int n = 0; n < 2; ++n) acc[a][b][m][n] = (f32x4){0.f, 0.f, 0.f, 0.f};
        cur = nxt; cA = nA; cB = nB; ++ui;
        if constexpr (ALIGN_EPI) { if (wr == 1) PG8_BAR; }
    }
    PG8_WAIT_V(0);
    if constexpr (!ALIGN_EPI) { if (wr == 0) PG8_BAR; }
    PG8_BAR;
    if constexpr (Epi::AFTER_DRAIN) { E.fused(acc, cur, wr, wc, fr, fq, lds, wid, lane); S.done(cur); }
#undef PG8_SA
#undef PG8_SB
#undef PG8_STAGE
#undef PG8_LDA
#undef PG8_LDB
#undef PG8_MMA
#undef PG8_WAIT_V
#undef PG8_WAIT_L
#undef PG8_BAR
#undef PG8_SCHED
}
}

#define LAS __attribute__((address_space(3)))
typedef pg8::bf16_t bf16_t;
typedef pg8::bf16x8 bf16x8;
typedef pg8::f32x4 f32x4;
typedef pg8::u32x4 u32x4;
typedef float f32x16 __attribute__((ext_vector_type(16)));
typedef unsigned u32x2 __attribute__((ext_vector_type(2)));

constexpr int T_TOK = 81920, T_PROMPT = 16384, DM = 1024, INW = 2816, FFW = 2816, NLAYER = 2;
constexpr int S_PROMPT = 2048, S_SAMPLE = 4096;
constexpr float LN_EPS = 1e-5f, ALPHA = 1.4142135623730951f, LOG2E = 1.4426950408889634f;
constexpr float QSCALE = 0.125f * LOG2E;
constexpr size_t MiB = 1u << 20;
constexpr size_t WS_WIN = 0, WS_WOUT = 11 * MiB, WS_WGU = 15 * MiB, WS_WD = 37 * MiB, WS_WSB = 48 * MiB;
constexpr size_t WS_XB = 64 * MiB, WS_MIX = 224 * MiB, WS_H = 384 * MiB, WS_END = 824 * MiB;
constexpr int LDS_BYTES = 147456;

struct Args {
    const float* in[19];
    float* out;
    unsigned char* ws;
};

__device__ __forceinline__ unsigned cvtpk(float lo, float hi) { return pg8::cvt_pk_bf16(lo, hi); }
__device__ __forceinline__ float bf2f(unsigned short h) { return __uint_as_float(((unsigned)h) << 16); }
__device__ __forceinline__ float bflo(unsigned w) { return __uint_as_float(w << 16); }
__device__ __forceinline__ float bfhi(unsigned w) { return __uint_as_float(w & 0xffff0000u); }
__device__ __forceinline__ float fast_exp2(float x) { return __builtin_amdgcn_exp2f(x); }
__device__ __forceinline__ float fast_rcp(float x) { return __builtin_amdgcn_rcpf(x); }
__device__ __forceinline__ float gelu_tanh(float x) {
    const float u = x * (0.7978845608028654f + 0.035677408136300125f * x * x);
    const float e = fast_exp2(-2.0f * LOG2E * u);
    return x * fast_rcp(1.0f + e);
}
__device__ __forceinline__ float silu_f(float x) { return x * fast_rcp(1.0f + fast_exp2(-LOG2E * x)); }
__device__ __forceinline__ float swap_max(float v) {
    auto rr = __builtin_amdgcn_permlane32_swap(__float_as_uint(v), __float_as_uint(v), false, false);
    return fmaxf(__uint_as_float(rr[0]), __uint_as_float(rr[1]));
}
__device__ __forceinline__ float swap_sum(float v) {
    auto rr = __builtin_amdgcn_permlane32_swap(__float_as_uint(v), __float_as_uint(v), false, false);
    return __uint_as_float(rr[0]) + __uint_as_float(rr[1]);
}
__device__ __forceinline__ float wave_sum(float v) {
#pragma unroll
    for (int o = 1; o < 64; o <<= 1) v += __shfl_xor(v, o);
    return v;
}

struct EpiIn {
    static constexpr bool PERM = true, AFTER_DRAIN = false;
    bf16_t* O;
    __device__ __forceinline__ void operator()(const f32x4 (&acc)[2][2][4][2], const pg8::Unit& u, int wr, int wc, int fr, int fq) const {
        const int row0 = u.pm * 256 + wr * 64 + fr, col0 = u.pn * 256 + wc * 32 + 8 * fq;
        const bool dog = u.pn < 2;
        const float sc = (u.pn == 2 || u.pn == 3 || u.pn == 8) ? QSCALE : 1.0f;
#pragma unroll
        for (int ai = 0; ai < 2; ++ai)
#pragma unroll
            for (int m = 0; m < 4; ++m) {
                bf16_t* rowp = O + (size_t)(row0 + ai * 128 + m * 16) * INW + col0;
#pragma unroll
                for (int bj = 0; bj < 2; ++bj) {
                    f32x4 v0 = acc[ai][bj][m][0], v1 = acc[ai][bj][m][1];
                    if (dog) {
#pragma unroll
                        for (int e = 0; e < 4; ++e) { v0[e] = gelu_tanh(v0[e]); v1[e] = gelu_tanh(v1[e]); }
                    }
                    v0 = v0 * sc; v1 = v1 * sc;
                    u32x4 w; w.x = cvtpk(v0[0], v0[1]); w.y = cvtpk(v0[2], v0[3]); w.z = cvtpk(v1[0], v1[1]); w.w = cvtpk(v1[2], v1[3]);
                    *(u32x4*)(rowp + bj * 128) = w;
                }
            }
    }
};
struct EpiGU {
    static constexpr bool PERM = true, AFTER_DRAIN = false;
    bf16_t* O;
    __device__ __forceinline__ void operator()(const f32x4 (&acc)[2][2][4][2], const pg8::Unit& u, int wr, int wc, int fr, int fq) const {
        const int row0 = u.pm * 256 + wr * 64 + fr, col0 = u.pn * 128 + wc * 32 + 8 * fq;
#pragma unroll
        for (int ai = 0; ai < 2; ++ai)
#pragma unroll
            for (int m = 0; m < 4; ++m) {
                bf16_t* rowp = O + (size_t)(row0 + ai * 128 + m * 16) * FFW + col0;
                f32x4 h0, h1;
#pragma unroll
                for (int e = 0; e < 4; ++e) { h0[e] = silu_f(acc[ai][0][m][0][e]) * acc[ai][1][m][0][e]; h1[e] = silu_f(acc[ai][0][m][1][e]) * acc[ai][1][m][1][e]; }
                u32x4 w; w.x = cvtpk(h0[0], h0[1]); w.y = cvtpk(h0[2], h0[3]); w.z = cvtpk(h1[0], h1[1]); w.w = cvtpk(h1[2], h1[3]);
                *(u32x4*)rowp = w;
            }
    }
};
struct EpiRes {
    static constexpr bool PERM = false, AFTER_DRAIN = false;
    float* X;
    __device__ __forceinline__ void operator()(const f32x4 (&acc)[2][2][4][2], const pg8::Unit& u, int wr, int wc, int fr, int fq) const {
        float* base = X + (size_t)(u.pm * 256 + wr * 64 + fr) * DM + u.pn * 256 + wc * 32 + 4 * fq;
#pragma unroll
        for (int ai = 0; ai < 2; ++ai)
#pragma unroll
            for (int m = 0; m < 4; ++m) {
                float* p = base + (size_t)(ai * 128 + m * 16) * DM;
#pragma unroll
                for (int bj = 0; bj < 2; ++bj)
#pragma unroll
                    for (int n = 0; n < 2; ++n) {
                        const f32x4 s = *(const f32x4*)(p + bj * 128 + n * 16);
                        *(f32x4*)(p + bj * 128 + n * 16) = s * ALPHA + acc[ai][bj][m][n];
                    }
                asm volatile("" ::: "memory");
            }
    }
};

__device__ __forceinline__ void transpose_item(const float* W, int K, int N, bf16_t* WT, int mode, LAS float* scr, int item, int lane) {
    const int nblk = N / 32, kb = item / nblk, nb = item % nblk, k0 = 64 * kb, n0 = 32 * nb;
    const int rowbase = (mode == 0) ? n0 : (256 * (n0 / 128) + (n0 % 128) + (mode == 2 ? 128 : 0));
#pragma unroll 8
    for (int i = 0; i < 32; ++i) { const int kk = 2 * i + (lane >> 5); scr[kk * 33 + (lane & 31)] = W[(size_t)(k0 + kk) * N + n0 + (lane & 31)]; }
    asm volatile("s_waitcnt lgkmcnt(0)" ::: "memory");
    const int c = lane & 7;
#pragma unroll
    for (int j = 0; j < 4; ++j) {
        const int n = (lane >> 3) + 8 * j; const LAS float* s = scr + (8 * c) * 33 + n;
        u32x4 o; o.x = cvtpk(s[0 * 33], s[1 * 33]); o.y = cvtpk(s[2 * 33], s[3 * 33]); o.z = cvtpk(s[4 * 33], s[5 * 33]); o.w = cvtpk(s[6 * 33], s[7 * 33]);
        *(u32x4*)(WT + (size_t)(rowbase + n) * K + k0 + 8 * c) = o;
    }
    asm volatile("s_waitcnt lgkmcnt(0)" ::: "memory");
}

__device__ __forceinline__ void prologue(const Args& a, LAS unsigned char* lds) {
    const int tid = fresh_tid(), lane = tid & 63, wave = __builtin_amdgcn_readfirstlane(tid >> 6);
    const int G = gridDim.x, gw = blockIdx.x * 8 + wave, NGW = G * 8;
    LAS float* scr = (LAS float*)(lds + wave * 16384);
    constexpr int I_IN = 16 * 88, I_OUT = 16 * 32, I_G = 16 * 88, I_D = 44 * 32, I_L = I_IN + I_OUT + 2 * I_G + I_D;
    unsigned char* ws = a.ws;
    for (int it = gw; it < NLAYER * I_L; it += NGW) {
        const int l = it / I_L; int r = it % I_L;
        if (r < I_IN) { transpose_item(a.in[2] + (size_t)l * DM * INW, DM, INW, (bf16_t*)(ws + WS_WIN) + (size_t)l * INW * DM, 0, scr, r, lane); continue; } r -= I_IN;
        if (r < I_OUT) { transpose_item(a.in[3] + (size_t)l * DM * DM, DM, DM, (bf16_t*)(ws + WS_WOUT) + (size_t)l * DM * DM, 0, scr, r, lane); continue; } r -= I_OUT;
        if (r < I_G) { transpose_item(a.in[14] + (size_t)l * DM * FFW, DM, FFW, (bf16_t*)(ws + WS_WGU) + (size_t)l * 2 * FFW * DM, 1, scr, r, lane); continue; } r -= I_G;
        if (r < I_G) { transpose_item(a.in[15] + (size_t)l * DM * FFW, DM, FFW, (bf16_t*)(ws + WS_WGU) + (size_t)l * 2 * FFW * DM, 2, scr, r, lane); continue; } r -= I_G;
        transpose_item(a.in[16] + (size_t)l * FFW * DM, FFW, DM, (bf16_t*)(ws + WS_WD) + (size_t)l * DM * FFW, 0, scr, r, lane);
    }
    const int gt = blockIdx.x * 512 + tid, NGT = G * 512;
    for (int i = gt; i < 131072 / 4; i += NGT) {
        const f32x4 v = *(const f32x4*)(a.in[6] + (size_t)i * 4);
        u32x2 o; o.x = cvtpk(v[0], v[1]); o.y = cvtpk(v[2], v[3]);
        *(u32x2*)((bf16_t*)(ws + WS_WSB) + (size_t)i * 4) = o;
    }
    bf16_t* XB = (bf16_t*)(ws + WS_XB);
    for (int i = gt; i < T_TOK * DM / 8; i += NGT) {
        const size_t e = (size_t)i * 8;
        const float* src = (e < (size_t)T_PROMPT * DM) ? (a.in[0] + e) : (a.in[1] + (e - (size_t)T_PROMPT * DM));
        const f32x4 v0 = *(const f32x4*)src, v1 = *(const f32x4*)(src + 4);
        u32x4 o; o.x = cvtpk(v0[0], v0[1]); o.y = cvtpk(v0[2], v0[3]); o.z = cvtpk(v1[0], v1[1]); o.w = cvtpk(v1[2], v1[3]);
        *(u32x4*)(XB + e) = o;
        *(f32x4*)(a.out + e) = v0; *(f32x4*)(a.out + e + 4) = v1;
    }
}

__device__ __forceinline__ void ln_phase(float* X, bf16_t* XB, const float* g, const float* b, bool write_b) {
    const int tid = fresh_tid(), lane = tid & 63, wave = __builtin_amdgcn_readfirstlane(tid >> 6);
    const int gw = blockIdx.x * 8 + wave, NGW = gridDim.x * 8;
    f32x4 gv[4], bv[4];
#pragma unroll
    for (int j = 0; j < 4; ++j) { gv[j] = *(const f32x4*)(g + 4 * lane + 256 * j); bv[j] = *(const f32x4*)(b + 4 * lane + 256 * j); }
    for (int row = gw; row < T_TOK; row += NGW) {
        float* xr = X + (size_t)row * DM + 4 * lane;
        f32x4 v[4]; float s = 0.f;
#pragma unroll
        for (int j = 0; j < 4; ++j) { v[j] = *(const f32x4*)(xr + 256 * j); s += (v[j][0] + v[j][1]) + (v[j][2] + v[j][3]); }
        const float mean = wave_sum(s) * (1.0f / DM); float s2 = 0.f;
#pragma unroll
        for (int j = 0; j < 4; ++j) { v[j] = v[j] - mean; s2 += (v[j][0] * v[j][0] + v[j][1] * v[j][1]) + (v[j][2] * v[j][2] + v[j][3] * v[j][3]); }
        const float rstd = 1.0f / sqrtf(wave_sum(s2) * (1.0f / DM) + LN_EPS);
#pragma unroll
        for (int j = 0; j < 4; ++j) {
            const f32x4 o = v[j] * rstd * gv[j] + bv[j];
            *(f32x4*)(xr + 256 * j) = o;
            if (write_b) { u32x2 w; w.x = cvtpk(o[0], o[1]); w.y = cvtpk(o[2], o[3]); *(u32x2*)(XB + (size_t)row * DM + 4 * lane + 256 * j) = w; }
        }
    }
}

#define MFMA32(a, b, c) __builtin_amdgcn_mfma_f32_32x32x16_bf16((a), (b), (c), 0, 0, 0)
#define MFMA16(a, b, c) __builtin_amdgcn_mfma_f32_16x16x32_bf16((a), (b), (c), 0, 0, 0)

constexpr int SG_P = 272;
__device__ __forceinline__ void sgu_unit(LAS unsigned char* lds, const bf16_t* H, bf16_t* MIX, int chunk, const float* lng, const float* lnb, const bf16_t* wsb, const float* bs) {
    const int tid = fresh_tid(), lane = tid & 63, wave = __builtin_amdgcn_readfirstlane(tid >> 6);
    const int t0 = chunk * 128;
    __syncthreads();
    {
        const int s = tid >> 2, q = tid & 3;
        const bf16_t* src = H + (size_t)(t0 + s) * INW + 256 + 64 * q;
        u32x4 raw[8]; float sum = 0.f;
#pragma unroll
        for (int i = 0; i < 8; ++i) { raw[i] = *(const u32x4*)(src + 8 * i);
#pragma unroll
            for (int e = 0; e < 4; ++e) sum += bflo(raw[i][e]) + bfhi(raw[i][e]); }
        sum += __shfl_xor(sum, 1); sum += __shfl_xor(sum, 2);
        const float mean = sum * (1.0f / 256.0f); float sq = 0.f;
#pragma unroll
        for (int i = 0; i < 8; ++i)
#pragma unroll
            for (int e = 0; e < 4; ++e) { const float a = bflo(raw[i][e]) - mean, b = bfhi(raw[i][e]) - mean; sq += a * a + b * b; }
        sq += __shfl_xor(sq, 1); sq += __shfl_xor(sq, 2);
        const float rstd = 1.0f / sqrtf(sq * (1.0f / 256.0f) + LN_EPS);
#pragma unroll
        for (int i = 0; i < 8; ++i)
#pragma unroll
            for (int e = 0; e < 4; ++e) {
                const int ch = 64 * q + 8 * i + 2 * e;
                const float a = (bflo(raw[i][e]) - mean) * rstd * lng[ch] + lnb[ch];
                const float b = (bfhi(raw[i][e]) - mean) * rstd * lng[ch + 1] + lnb[ch + 1];
                const unsigned w = cvtpk(a, b);
                *(LAS unsigned short*)(lds + ch * SG_P + s * 2) = (unsigned short)(w & 0xffffu);
                *(LAS unsigned short*)(lds + (ch + 1) * SG_P + s * 2) = (unsigned short)(w >> 16);
            }
    }
    __syncthreads();
    {
        const int g = wave >> 1, th = wave & 1, fr = lane & 15, fq = lane >> 4;
        f32x4 acc[4][4];
#pragma unroll
        for (int ct = 0; ct < 4; ++ct)
#pragma unroll
            for (int tt = 0; tt < 4; ++tt) acc[ct][tt] = (f32x4){0.f, 0.f, 0.f, 0.f};
        const bf16_t* wg = wsb + (size_t)g * 128 * 128;
#pragma unroll
        for (int ks = 0; ks < 4; ++ks) {
            bf16x8 xf[4], yf[4];
#pragma unroll
            for (int ct = 0; ct < 4; ++ct) xf[ct] = *(const LAS bf16x8*)(lds + (g * 64 + 16 * ct + fr) * SG_P + (32 * ks + 8 * fq) * 2);
#pragma unroll
            for (int tt = 0; tt < 4; ++tt) yf[tt] = *(const bf16x8*)(wg + (size_t)(64 * th + 16 * tt + fr) * 128 + 32 * ks + 8 * fq);
#pragma unroll
            for (int ct = 0; ct < 4; ++ct)
#pragma unroll
                for (int tt = 0; tt < 4; ++tt) acc[ct][tt] = MFMA16(xf[ct], yf[tt], acc[ct][tt]);
        }
#pragma unroll
        for (int tt = 0; tt < 4; ++tt) {
            const int t = 64 * th + 16 * tt + fr;
            const float bias = bs[g * 128 + t];
#pragma unroll
            for (int ct = 0; ct < 4; ++ct) {
                const int c = g * 64 + 16 * ct + 4 * fq;
                const u32x2 uu = *(const u32x2*)(H + (size_t)(t0 + t) * INW + c);
                const float o0 = bflo(uu.x) * (acc[ct][tt][0] + bias), o1 = bfhi(uu.x) * (acc[ct][tt][1] + bias);
                const float o2 = bflo(uu.y) * (acc[ct][tt][2] + bias), o3 = bfhi(uu.y) * (acc[ct][tt][3] + bias);
                u32x2 w; w.x = cvtpk(o0, o1); w.y = cvtpk(o2, o3);
                *(u32x2*)(MIX + (size_t)(t0 + t) * DM + c) = w;
            }
        }
    }
}

constexpr int KP = 272, VP = 272, ATT_KBUF = 64 * KP, ATT_VBUF = 64 * VP, ATT_BUF = ATT_KBUF + ATT_VBUF, ATT_Q_OFF = 2 * ATT_BUF;
typedef short v4i16_t __attribute__((ext_vector_type(4)));
__device__ __forceinline__ v4i16_t vtr(const LAS unsigned char* p) { return __builtin_amdgcn_ds_read_tr16_b64_v4i16((LAS v4i16_t*)p); }
static_assert(ATT_Q_OFF + 8 * 32 * KP <= LDS_BYTES, "attention LDS map");
__device__ __forceinline__ int perm16(int x) { return (x & 3) | ((x & 4) << 1) | ((x & 8) >> 1); }
__device__ __forceinline__ void dattn_block(LAS unsigned char* kbuf, LAS unsigned char* vbuf, LAS unsigned char* qlds, int c, int kt, bool first, int kb, int q0, float dq, float slope2,
                                            f32x16 (&O)[4], float& negm, float& lrun, int l32, int hi) {
    constexpr float THR = 8.0f, SKIP = -36.0f;
    f32x16 sv;
    float dql = dq - (float)(32 * kt); asm volatile("" : "+v"(dql));
    if (kb + 31 <= q0 || kb >= q0 + 31) {
        const float sg = (kb + 31 <= q0) ? 1.0f : -1.0f;
        const float coef = sg * slope2, base = negm - coef * dql;
#pragma unroll
        for (int j = 0; j < 16; ++j) sv[j] = fmaf(coef, (float)((j & 3) + 8 * (j >> 2)), base);
    } else {
#pragma unroll
        for (int j = 0; j < 16; ++j) sv[j] = fmaf(-slope2, fabsf(dql - (float)((j & 3) + 8 * (j >> 2))), negm);
    }
#pragma unroll
    for (int s = 0; s < 4; ++s) {
        const bf16x8 kf = *(const LAS bf16x8*)(kbuf + (32 * kt + l32) * KP + (c * 64 + s * 16 + hi * 8) * 2);
        const bf16x8 qfr = *(const LAS bf16x8*)(qlds + (c * 64 + s * 16) * 2);
        sv = MFMA32(kf, qfr, sv);
        if (s & 1) __builtin_amdgcn_sched_barrier(0);
    }
    float mx = fmaxf(fmaxf(sv[0], sv[1]), sv[2]);
#pragma unroll
    for (int j = 3; j < 15; j += 2) mx = fmaxf(fmaxf(mx, sv[j]), sv[j + 1]);
    mx = fmaxf(mx, sv[15]);
    mx = swap_max(mx);
    if (first || __any(mx > THR)) {
        const float delta = (first || mx > THR) ? mx : 0.0f;
        const float alpha = fast_exp2(-delta);
        negm -= delta; lrun *= alpha;
#pragma unroll
        for (int j = 0; j < 16; ++j) sv[j] -= delta;
#pragma unroll
        for (int et = 0; et < 4; ++et)
#pragma unroll
            for (int j = 0; j < 16; ++j) asm volatile("v_mul_f32 %0, %0, %1" : "+v"(O[et][j]) : "v"(alpha));
    }
    float ps = 0.f;
#pragma unroll
    for (int j = 0; j < 16; ++j) { sv[j] = fast_exp2(sv[j]); ps += sv[j]; }
    lrun += ps;
    bf16x8 pf0, pf1;
    {
        u32x4 w;
        w.x = cvtpk(sv[0], sv[1]); w.y = cvtpk(sv[2], sv[3]); w.z = cvtpk(sv[4], sv[5]); w.w = cvtpk(sv[6], sv[7]); pf0 = __builtin_bit_cast(bf16x8, w);
        w.x = cvtpk(sv[8], sv[9]); w.y = cvtpk(sv[10], sv[11]); w.z = cvtpk(sv[12], sv[13]); w.w = cvtpk(sv[14], sv[15]); pf1 = __builtin_bit_cast(bf16x8, w);
    }
#pragma unroll
    for (int et = 0; et < 4; ++et) {
        const v4i16_t a0 = vtr(vbuf + (32 * kt) * VP + 64 * et), a1 = vtr(vbuf + (32 * kt + 8) * VP + 64 * et);
        const v4i16_t b0 = vtr(vbuf + (32 * kt + 16) * VP + 64 * et), b1 = vtr(vbuf + (32 * kt + 24) * VP + 64 * et);
        const bf16x8 vf0 = (bf16x8){a0[0], a0[1], a0[2], a0[3], a1[0], a1[1], a1[2], a1[3]};
        const bf16x8 vf1 = (bf16x8){b0[0], b0[1], b0[2], b0[3], b1[0], b1[1], b1[2], b1[3]};
        O[et] = MFMA32(vf0, pf0, O[et]);
        O[et] = MFMA32(vf1, pf1, O[et]);
    }
}
__device__ __forceinline__ void dattn_write_k(LAS unsigned char* kbuf, int kkey0, int kpart, const u32x4& r0, const u32x4& r1) {
    *(LAS u32x4*)(kbuf + kkey0 * KP + kpart * 16) = r0;
    *(LAS u32x4*)(kbuf + (kkey0 + 32) * KP + kpart * 16) = r1;
}
__device__ __forceinline__ void dattn_unit(LAS unsigned char* lds, const bf16_t* H, bf16_t* MIX, int tok0, int S, int h, int qb, float lam, float slope2,
                                           const float* subg, float outscale) {
    const int tid = fresh_tid(), lane = tid & 63, wave = __builtin_amdgcn_readfirstlane(tid >> 6), l32 = lane & 31, hi = lane >> 5;
    const int q0 = qb * 256 + wave * 32;
    LAS unsigned char* qlds = lds + ATT_Q_OFF + wave * (32 * KP) + l32 * KP + hi * 16;
    const int kkey0 = tid >> 4, kpart = tid & 15;
    const bf16_t* kg = H + (size_t)(tok0 + kkey0) * INW + 1024 + h * 128 + kpart * 8;
    const bf16_t* vg = kg + 512;
    const int vtr_off = (4 * hi + ((lane & 15) >> 2)) * VP + 32 * ((lane >> 4) & 1) + 8 * (lane & 3);
    const int nt = S / 64;
    __syncthreads();
    {
        const bf16_t* qsrc = H + (size_t)(tok0 + q0) * INW + 512 + h * 128;
#pragma unroll
        for (int i = 0; i < 8; ++i) {
            const int ch = lane + 64 * i, row = ch >> 4, part = ch & 15;
            *(LAS u32x4*)(lds + ATT_Q_OFF + wave * (32 * KP) + row * KP + part * 16) = *(const u32x4*)(qsrc + (size_t)row * INW + part * 8);
        }
    }
    int lo = 4 * qb - 1, hiT = 4 * qb + 4; bool tog = false;
    int tcur = 4 * qb;
    {
        const size_t adv = (size_t)tcur * 64 * INW;
        const u32x4 a0 = *(const u32x4*)(kg + adv), a1 = *(const u32x4*)(kg + adv + (size_t)32 * INW);
        const u32x4 b0 = *(const u32x4*)(vg + adv), b1 = *(const u32x4*)(vg + adv + (size_t)32 * INW);
        dattn_write_k(lds, kkey0, kpart, a0, a1);
        dattn_write_k(lds + ATT_KBUF, kkey0, kpart, b0, b1);
    }
    f32x16 O0[4], O1[4];
#pragma unroll
    for (int et = 0; et < 4; ++et)
#pragma unroll
        for (int j = 0; j < 16; ++j) { O0[et][j] = 0.f; O1[et][j] = 0.f; }
    float negm0 = 0.f, negm1 = 0.f, lrun0 = 0.f, lrun1 = 0.f;
#pragma clang loop unroll(disable)
    for (int step = 0; step < nt; ++step) {
        LAS unsigned char* kb_ = lds + (step & 1) * ATT_BUF;
        LAS unsigned char* vb_ = kb_ + ATT_KBUF;
        LAS unsigned char* kn_ = lds + ((step & 1) ^ 1) * ATT_BUF;
        LAS unsigned char* vn_ = kn_ + ATT_KBUF;
        __syncthreads();
        const int k0 = tcur * 64;
        const bool more = step + 1 < nt;
        size_t adv = 0;
        if (more) {
            int tn;
            if (step + 1 < 4) tn = 4 * qb + step + 1;
            else { const bool takeLo = (lo >= 0) && (hiT >= nt || tog); tog = !tog; if (takeLo) { tn = lo; --lo; } else { tn = hiT; ++hiT; } }
            tcur = tn;
            adv = (size_t)tn * 64 * INW;
        }
        u32x4 r0, r1;
        if (more) { r0 = *(const u32x4*)(kg + adv); r1 = *(const u32x4*)(kg + adv + (size_t)32 * INW); }
        const float dq = (float)(q0 + l32 - k0 - 4 * hi);
        dattn_block(kb_, vb_ + vtr_off, qlds, 0, 0, step == 0, k0, q0, dq, slope2, O0, negm0, lrun0, l32, hi);
        __builtin_amdgcn_sched_barrier(0);
        if (more) { dattn_write_k(kn_, kkey0, kpart, r0, r1); r0 = *(const u32x4*)(vg + adv); r1 = *(const u32x4*)(vg + adv + (size_t)32 * INW); }
        dattn_block(kb_, vb_ + vtr_off, qlds, 0, 1, false, k0 + 32, q0, dq, slope2, O0, negm0, lrun0, l32, hi);
        __builtin_amdgcn_sched_barrier(0);
        dattn_block(kb_, vb_ + vtr_off, qlds, 1, 0, step == 0, k0, q0, dq, slope2, O1, negm1, lrun1, l32, hi);
        __builtin_amdgcn_sched_barrier(0);
        if (more) dattn_write_k(vn_, kkey0, kpart, r0, r1);
        dattn_block(kb_, vb_ + vtr_off, qlds, 1, 1, false, k0 + 32, q0, dq, slope2, O1, negm1, lrun1, l32, hi);
        __builtin_amdgcn_sched_barrier(0);
    }
    const float r0 = fast_rcp(swap_sum(lrun0)), r1 = lam * fast_rcp(swap_sum(lrun1));
    float ss = 0.f;
#pragma unroll
    for (int et = 0; et < 4; ++et)
#pragma unroll
        for (int j = 0; j < 16; ++j) { const float o = O0[et][j] * r0 - O1[et][j] * r1; O0[et][j] = o; ss += o * o; }
    ss = swap_sum(ss);
    const float rms = outscale / sqrtf(ss * (1.0f / 128.0f) + LN_EPS);
    bf16_t* orow = MIX + (size_t)(tok0 + q0 + l32) * DM + 256 + h * 128;
#pragma unroll
    for (int et = 0; et < 4; ++et)
#pragma unroll
        for (int jq = 0; jq < 4; ++jq) {
            const int e = 32 * et + 8 * jq + 4 * hi;
            const f32x4 gq = *(const f32x4*)(subg + e);
            u32x2 w; w.x = cvtpk(O0[et][4 * jq] * rms * gq[0], O0[et][4 * jq + 1] * rms * gq[1]);
            w.y = cvtpk(O0[et][4 * jq + 2] * rms * gq[2], O0[et][4 * jq + 3] * rms * gq[3]);
            *(u32x2*)(orow + e) = w;
        }
}

__device__ __forceinline__ void na_unit(const bf16_t* H, bf16_t* MIX, int tok0, int rows, int r, const float* rpb) {
    const int tid = fresh_tid(), lane = tid & 63, wave = __builtin_amdgcn_readfirstlane(tid >> 6), fr = lane & 15, fq = lane >> 4;
    const int h = wave >> 1;
    const int rs = min(max(r - 4, 0), rows - 8);
    for (int cgi = 0; cgi < 2; ++cgi) {
        const int cgp = 2 * (wave & 1) + cgi;
        const int kc0 = (cgp == 0) ? 0 : (cgp == 1) ? 8 : (cgp == 2) ? 24 : 32;
        const int col = 16 * cgp + fr;
        const int qtok = tok0 + r * 64 + col;
        bf16x8 qf[2];
#pragma unroll
        for (int ks = 0; ks < 2; ++ks) qf[ks] = *(const bf16x8*)(H + (size_t)qtok * INW + 2048 + h * 64 + ks * 32 + fq * 8);
        f32x4 sc[8][2];
#pragma unroll
        for (int i = 0; i < 8; ++i)
#pragma unroll
            for (int t = 0; t < 2; ++t) {
                const int ktok = tok0 + (rs + i) * 64 + kc0 + 16 * t + fr;
                const bf16_t* kp = H + (size_t)ktok * INW + 2304 + h * 64 + fq * 8;
                const bf16x8 k0 = *(const bf16x8*)kp, k1 = *(const bf16x8*)(kp + 32);
                f32x4 a = (f32x4){0.f, 0.f, 0.f, 0.f};
                a = MFMA16(k0, qf[0], a); a = MFMA16(k1, qf[1], a);
                sc[i][t] = a;
            }
        const int cs = min(max(col - 8, 0), 48);
        float mx = -1e30f;
#pragma unroll
        for (int i = 0; i < 8; ++i) {
            const int row_off = rs + i - r + 7;
#pragma unroll
            for (int t = 0; t < 2; ++t)
#pragma unroll
                for (int ii = 0; ii < 4; ++ii) {
                    const int kc = kc0 + 16 * t + 4 * fq + ii;
                    const bool valid = (kc >= cs) && (kc < cs + 16);
                    const int col_off = valid ? (kc - col + 15) : 0;
                    const float bias = rpb[(h * 15 + row_off) * 31 + col_off] * LOG2E;
                    const float v = valid ? (sc[i][t][ii] + bias) : -1e30f;
                    sc[i][t][ii] = v; mx = fmaxf(mx, v);
                }
        }
        mx = fmaxf(mx, __shfl_xor(mx, 16)); mx = fmaxf(mx, __shfl_xor(mx, 32));
        float sum = 0.f;
#pragma unroll
        for (int i = 0; i < 8; ++i)
#pragma unroll
            for (int t = 0; t < 2; ++t)
#pragma unroll
                for (int ii = 0; ii < 4; ++ii) { const float p = fast_exp2(sc[i][t][ii] - mx); sc[i][t][ii] = p; sum += p; }
        sum += __shfl_xor(sum, 16); sum += __shfl_xor(sum, 32);
        const float rinv = fast_rcp(sum);
        f32x4 o[4];
#pragma unroll
        for (int et = 0; et < 4; ++et) o[et] = (f32x4){0.f, 0.f, 0.f, 0.f};
#pragma unroll
        for (int i = 0; i < 8; ++i) {
            u32x4 w; w.x = cvtpk(sc[i][0][0], sc[i][0][1]); w.y = cvtpk(sc[i][0][2], sc[i][0][3]); w.z = cvtpk(sc[i][1][0], sc[i][1][1]); w.w = cvtpk(sc[i][1][2], sc[i][1][3]);
            const bf16x8 pf = __builtin_bit_cast(bf16x8, w);
            const bf16_t* vbase = H + (size_t)(tok0 + (rs + i) * 64 + kc0 + 4 * fq) * INW + 2560 + h * 64 + fr;
#pragma unroll
            for (int et = 0; et < 4; ++et) {
                bf16x8 vf;
#pragma unroll
                for (int ii = 0; ii < 4; ++ii) {
                    vf[ii] = (short)vbase[(size_t)ii * INW + 16 * et];
                    vf[4 + ii] = (short)vbase[(size_t)(16 + ii) * INW + 16 * et];
                }
                o[et] = MFMA16(vf, pf, o[et]);
            }
        }
        bf16_t* orow = MIX + (size_t)qtok * DM + 768 + h * 64 + 4 * fq;
#pragma unroll
        for (int et = 0; et < 4; ++et) {
            u32x2 w; w.x = cvtpk(o[et][0] * rinv, o[et][1] * rinv); w.y = cvtpk(o[et][2] * rinv, o[et][3] * rinv);
            *(u32x2*)(orow + 16 * et) = w;
        }
    }
}

__global__ void __launch_bounds__(512, 2) fwd_megakernel(Args a) {
    extern __shared__ __attribute__((aligned(16))) unsigned char lds_raw[];
    LAS unsigned char* lds = (LAS unsigned char*)lds_raw;
    cg::grid_group grid = cg::this_grid();
    const int G = gridDim.x, bx = blockIdx.x;
    unsigned char* ws = a.ws;
    bf16_t* XB = (bf16_t*)(ws + WS_XB); bf16_t* MIX = (bf16_t*)(ws + WS_MIX); bf16_t* Hb = (bf16_t*)(ws + WS_H);
    float* OUT = a.out;

    prologue(a, lds);
    grid.sync();

    for (int l = 0; l < NLAYER; ++l) {
        {
            pg8::Gemm g{XB, (const bf16_t*)(ws + WS_WIN) + (size_t)l * INW * DM, T_TOK, INW, DM};
            pg8::StaticOrder S; S.init(T_TOK, INW, G, bx);
            EpiIn E{Hb};
            pg8::gemm_phase<EpiIn, pg8::StaticOrder, true, true>(lds, g, S, E);
        }
        grid.sync();
        {
            const int lane = fresh_tid() & 63;
            const float lam_init = (l == 0) ? 0.2f : (0.8f - 0.6f * 0.7408182206817179f);
            const float s1 = wave_sum(a.in[8][l * 64 + lane] * a.in[9][l * 64 + lane]);
            const float s2 = wave_sum(a.in[10][l * 64 + lane] * a.in[11][l * 64 + lane]);
            const float lam = __uint_as_float(__builtin_amdgcn_readfirstlane(__float_as_uint(expf(s1) - expf(s2) + lam_init)));
            const float* subg = a.in[12] + l * 128;
            const int x = bx & 7, m = bx >> 3;
            for (int u = bx; u < 1280; u += G) {
                int tok0, S, h, qb;
                if (u < 1024) { const int j = u >> 8, uu = u & 255, xx = uu & 7, mm = uu >> 3; const int bh = j * 16 + xx * 2 + (mm >> 4); qb = mm & 15; S = S_SAMPLE; tok0 = T_PROMPT + (bh >> 2) * S_SAMPLE; h = bh & 3; }
                else { const int uu = u - 1024, xx = uu & 7, mm = uu >> 3; const int bh = xx * 4 + (mm >> 3); qb = mm & 7; S = S_PROMPT; tok0 = (bh >> 2) * S_PROMPT; h = bh & 3; }
                const float slope2 = LOG2E * ((h == 0) ? 0.25f : (h == 1) ? 0.0625f : (h == 2) ? 0.015625f : 0.00390625f);
                dattn_unit(lds, Hb, MIX, tok0, S, h, qb, lam, slope2, subg, 1.0f - lam_init);
            }
            for (int c = bx; c < T_TOK / 128; c += G)
                sgu_unit(lds, Hb, MIX, c, a.in[4] + l * 256, a.in[5] + l * 256, (const bf16_t*)(ws + WS_WSB) + (size_t)l * 4 * 128 * 128, a.in[7] + l * 512);
            const int nrows = T_TOK / 64;
            for (int k = bx; k < nrows; k += G) {
                int R = k;
                if (G == 256) R = x * 160 + m * 5 + (k >> 8);
                int tok0, rows, r;
                if (R < 256) { tok0 = (R >> 5) * S_PROMPT; rows = 32; r = R & 31; }
                else { const int Rp = R - 256; tok0 = T_PROMPT + (Rp >> 6) * S_SAMPLE; rows = 64; r = Rp & 63; }
                na_unit(Hb, MIX, tok0, rows, r, a.in[13] + l * 4 * 15 * 31);
            }
        }
        grid.sync();
        {
            pg8::Gemm g{MIX, (const bf16_t*)(ws + WS_WOUT) + (size_t)l * DM * DM, T_TOK, DM, DM};
            pg8::StaticOrder S; S.init(T_TOK, DM, G, bx);
            EpiRes E{OUT};
            pg8::gemm_phase<EpiRes, pg8::StaticOrder, true, true>(lds, g, S, E);
        }
        grid.sync();
        ln_phase(OUT, XB, a.in[17] + (l * 2 + 0) * DM, a.in[18] + (l * 2 + 0) * DM, true);
        grid.sync();
        {
            pg8::Gemm g{XB, (const bf16_t*)(ws + WS_WGU) + (size_t)l * 2 * FFW * DM, T_TOK, 2 * FFW, DM};
            pg8::StaticOrder S; S.init(T_TOK, 2 * FFW, G, bx);
            EpiGU E{Hb};
            pg8::gemm_phase<EpiGU, pg8::StaticOrder, true, true>(lds, g, S, E);
        }
        grid.sync();
        {
            pg8::Gemm g{Hb, (const bf16_t*)(ws + WS_WD) + (size_t)l * DM * FFW, T_TOK, DM, FFW};
            pg8::StaticOrder S; S.init(T_TOK, DM, G, bx);
            EpiRes E{OUT};
            pg8::gemm_phase<EpiRes, pg8::StaticOrder, true, true>(lds, g, S, E);
        }
        grid.sync();
        ln_phase(OUT, XB, a.in[17] + (l * 2 + 1) * DM, a.in[18] + (l * 2 + 1) * DM, l + 1 < NLAYER);
        if (l + 1 < NLAYER) grid.sync();
    }
}

extern "C" void kernel_launch(void* const* d_in, const int* in_sizes, int n_in, void* d_out, int out_size, void* d_ws, size_t ws_size, hipStream_t stream) {
    static int grid_blocks = 0;
    if (grid_blocks == 0) {
        if (n_in != 19 || ws_size < WS_END) { fprintf(stderr, "kernel_launch: unexpected n_in %d / ws_size %zu\n", n_in, ws_size); grid_blocks = -1; return; }
        int dev = 0, cus = 0, per_cu = 0;
        hipGetDevice(&dev);
        hipDeviceGetAttribute(&cus, hipDeviceAttributeMultiprocessorCount, dev);
        if (hipFuncSetAttribute((const void*)fwd_megakernel, hipFuncAttributeMaxDynamicSharedMemorySize, LDS_BYTES) != hipSuccess) fprintf(stderr, "kernel_launch: hipFuncSetAttribute failed\n");
        if (hipOccupancyMaxActiveBlocksPerMultiprocessor(&per_cu, (const void*)fwd_megakernel, 512, LDS_BYTES) != hipSuccess || per_cu < 1) { fprintf(stderr, "kernel_launch: occupancy query says %d\n", per_cu); per_cu = 1; }
        (void)hipGetLastError();
        grid_blocks = cus * per_cu;
    }
    if (grid_blocks < 0) return;
    Args a{};
    for (int i = 0; i < 19; ++i) a.in[i] = (const float*)d_in[i];
    a.out = (float*)d_out; a.ws = (unsigned char*)d_ws;
    void* args[] = {&a};
    hipError_t e = hipLaunchCooperativeKernel((const void*)fwd_megakernel, dim3(grid_blocks), dim3(512), args, LDS_BYTES, stream);
    if (e != hipSuccess) fprintf(stderr, "cooperative launch failed: %s (grid %d)\n", hipGetErrorString(e), grid_blocks);
}
```

```cpp
#include <hip/hip_runtime.h>
#include <hip/hip_cooperative_groups.h>
#include <cstdio>
#include <cstdint>
namespace cg = cooperative_groups;

__device__ __forceinline__ int fresh_tid() { int t = threadIdx.x; asm volatile("" : "+v"(t)); return t; }
namespace pg8 {
#define PG8_LAS __attribute__((address_space(3)))
typedef unsigned short bf16_t;
typedef short bf16x8 __attribute__((ext_vector_type(8)));
typedef float f32x4 __attribute__((ext_vector_type(4)));
typedef unsigned u32x4 __attribute__((ext_vector_type(4)));
constexpr int BM = 256, BK = 64, HALF = 128, HTB = HALF * BK * 2  , STAGE_BYTES = 8 * HTB, NXCD = 8, WGM = 8;

__host__ __device__ __forceinline__ int lds_byte(int r, int c) { const int st = (r >> 4) * 2 + (c >> 5), rr = r & 15, cc = c & 31, ob = rr * 64 + cc * 2; return st * 1024 + (ob ^ (((ob >> 9) & 1) << 5)); }
__host__ __device__ __forceinline__ void stage_rc(int b, int& R, int& C) { const int st = b / 1024, sb = b % 1024, swz = sb ^ (((sb >> 9) & 1) << 5); R = (st >> 1) * 16 + swz / 64; C = (st & 1) * 32 + (swz % 64) / 2; }
__host__ __device__ __forceinline__ int perm32(int rho) { const int n = rho >> 4, i = rho & 15; return 8 * (i >> 2) + 4 * n + (i & 3); }

struct Unit { int pm, pn; };
struct Gemm { const bf16_t* A; const bf16_t* Bt; int M, N, K; };

struct StaticOrder {
    int nM, nN, nwg, G, c;
    __host__ __device__ void init(int M, int N, int G_, int c_) { nM = M / BM; nN = N / BM; nwg = nM * nN; G = G_; c = c_; }
    __host__ __device__ bool next(int i, Unit& u) const {
        const long L = (long)i * G + c; if (L >= nwg) return false;
        int wgid = (int)L; { const int q = nwg / NXCD, r = nwg % NXCD, xcd = wgid % NXCD, off = wgid / NXCD; wgid = (xcd < r ? xcd * (q + 1) : r * (q + 1) + (xcd - r) * q) + off; }
        const int nig = WGM * nN, gid = wgid / nig, fm = gid * WGM, gsz = (nM - fm) < WGM ? (nM - fm) : WGM;
        u.pm = fm + ((wgid % nig) % gsz); u.pn = (wgid % nig) / gsz; return true;
    }
    __device__ __forceinline__ void a_ready(const Unit&) const {}
    __device__ __forceinline__ void done(const Unit&) const {}
};

__device__ __forceinline__ unsigned cvt_pk_bf16(float lo, float hi) { unsigned r; asm volatile("v_cvt_pk_bf16_f32 %0, %1, %2" : "=v"(r) : "v"(lo), "v"(hi)); return r; }
template <class Epi, class Sched, bool ALIGN_EPI = false, bool SP2 = false>
__device__ __forceinline__ void gemm_phase(PG8_LAS unsigned char* lds, const Gemm g, const Sched& S, const Epi& E) {
    const int tid = fresh_tid(), wid = __builtin_amdgcn_readfirstlane(tid >> 6), lane = tid & 63, wr = wid >> 2, wc = wid & 3, fr = lane & 15, fq = lane >> 4;
    const int K = g.K, nt = K / BK;
    unsigned voffA[2], voffB[2];
#pragma unroll
    for (int i = 0; i < 2; ++i) { int R, C; stage_rc(tid * 16 + i * 8192, R, C); const int Rb = Epi::PERM ? ((R & ~31) + perm32(R & 31)) : R;
        voffA[i] = (unsigned)(R * K + C) * 2u; voffB[i] = (unsigned)(Rb * K + C) * 2u; }
    const size_t kstep = (size_t)(BK * 2);
    const size_t hstep = (size_t)HALF * K * 2;
    const size_t tstep = 2 * hstep;
    const unsigned ldsw = (unsigned)wid * 1024u;
    const int aoff = lds_byte(wr * 64 + fr, fq * 8), boff = lds_byte(wc * 32 + fr, fq * 8);
#define PG8_SA(b, h) (((b) * 2 + (h)) * HTB)
#define PG8_SB(b, h) ((4 + (b) * 2 + (h)) * HTB)
#define PG8_STAGE(bufoff, gbase, voff) do { _Pragma("unroll") for (int _i = 0; _i < 2; ++_i) \
        __builtin_amdgcn_global_load_lds((const unsigned*)((const char*)(gbase) + (voff)[_i]), (PG8_LAS unsigned*)(lds + (bufoff) + ldsw + _i * 8192), 16, 0, 0); } while (0)
#define PG8_LDA(dst, b, h) do { _Pragma("unroll") for (int m = 0; m < 4; ++m) _Pragma("unroll") for (int k = 0; k < 2; ++k) dst[m][k] = *(const PG8_LAS bf16x8*)(lds + PG8_SA(b, h) + aoff + m * 2048 + k * 1024); } while (0)
#define PG8_LDB(dst, b, h) do { _Pragma("unroll") for (int n = 0; n < 2; ++n) _Pragma("unroll") for (int k = 0; k < 2; ++k) dst[n][k] = *(const PG8_LAS bf16x8*)(lds + PG8_SB(b, h) + boff + n * 2048 + k * 1024); } while (0)
#define PG8_MMA(ai, bj, At, Bt) do { __builtin_amdgcn_s_setprio(1); _Pragma("unroll") for (int m = 0; m < 4; ++m) _Pragma("unroll") for (int n = 0; n < 2; ++n) _Pragma("unroll") for (int k = 0; k < 2; ++k) \
        acc[ai][bj][m][n] = __builtin_amdgcn_mfma_f32_16x16x32_bf16(Bt[n][k], At[m][k], acc[ai][bj][m][n], 0, 0, 0); __builtin_amdgcn_s_setprio(0); } while (0)
#define PG8_WAIT_V(n) asm volatile("s_waitcnt vmcnt(" #n ")" ::: "memory")
#define PG8_WAIT_L(n) asm volatile("s_waitcnt lgkmcnt(" #n ")" ::: "memory")
#define PG8_BAR __builtin_amdgcn_s_barrier()
#define PG8_SCHED __builtin_amdgcn_sched_barrier(0)
    Unit cur, nxt; int ui = 0;
    if (!S.next(0, cur)) return;
    f32x4 acc[2][2][4][2];
#pragma unroll
    for (int a = 0; a < 2; ++a)
#pragma unroll
        for (int b = 0; b < 2; ++b)
#pragma unroll
            for (int m = 0; m < 4; ++m)
#pragma unroll
                for (int n = 0; n < 2; ++n) acc[a][b][m][n] = (f32x4){0.f, 0.f, 0.f, 0.f};
    bf16x8 At[4][2], B0[2][2], B1[2][2];
    const char* cA = (const char*)g.A + (size_t)cur.pm * tstep; const char* cB = (const char*)g.Bt + (size_t)cur.pn * tstep;
    S.a_ready(cur);
    if constexpr (SP2) {
        PG8_STAGE(PG8_SB(0, 0), cB, voffB); PG8_STAGE(PG8_SB(0, 1), cB + hstep, voffB); PG8_STAGE(PG8_SA(0, 0), cA, voffA); PG8_STAGE(PG8_SA(0, 1), cA + hstep, voffA);
        if (wr == 1) PG8_BAR;
        PG8_WAIT_V(2); PG8_BAR;
        PG8_STAGE(PG8_SB(1, 0), cB + kstep, voffB); PG8_STAGE(PG8_SA(1, 0), cA + kstep, voffA); PG8_STAGE(PG8_SB(1, 1), cB + hstep + kstep, voffB);
        PG8_WAIT_V(6); PG8_BAR;
    } else {
        PG8_STAGE(PG8_SB(0, 0), cB, voffB); PG8_STAGE(PG8_SA(0, 0), cA, voffA); PG8_STAGE(PG8_SB(0, 1), cB + hstep, voffB); PG8_STAGE(PG8_SA(0, 1), cA + hstep, voffA);
        if (wr == 1) PG8_BAR;
        PG8_WAIT_V(4); PG8_BAR;
        PG8_STAGE(PG8_SB(1, 0), cB + kstep, voffB); PG8_STAGE(PG8_SA(1, 0), cA + kstep, voffA); PG8_STAGE(PG8_SB(1, 1), cB + hstep + kstep, voffB);
        PG8_WAIT_V(6); PG8_BAR;
    }
    for (;;) {
        const bool has_next = S.next(ui + 1, nxt);
        const char* nA = has_next ? (const char*)g.A + (size_t)nxt.pm * tstep : cA; const char* nB = has_next ? (const char*)g.Bt + (size_t)nxt.pn * tstep : cB;
        for (int t = 0; t < nt; t += 2) {
            const bool last = (t == nt - 2);
            const char* a1 = cA + (size_t)(t + 1) * kstep;
            const char* a2 = last ? nA : cA + (size_t)(t + 2) * kstep; const char* b2 = last ? nB : cB + (size_t)(t + 2) * kstep;
            const char* a3 = a2 + kstep; const char* b3 = b2 + kstep;
            if (last && has_next) S.a_ready(nxt);
            if constexpr (SP2) {
            PG8_LDB(B0, 0, 0); PG8_LDB(B1, 0, 1); PG8_SCHED; PG8_LDA(At, 0, 0); PG8_STAGE(PG8_SA(1, 1), a1 + hstep, voffA);
            PG8_WAIT_V(8); PG8_WAIT_L(0); PG8_BAR; PG8_MMA(0, 0, At, B0); PG8_MMA(0, 1, At, B1); PG8_BAR; PG8_SCHED;
            PG8_LDA(At, 0, 1); PG8_STAGE(PG8_SB(0, 0), b2, voffB); PG8_STAGE(PG8_SB(0, 1), b2 + hstep, voffB); PG8_STAGE(PG8_SA(0, 0), a2, voffA);
            PG8_WAIT_V(8); PG8_WAIT_L(0); PG8_BAR; PG8_MMA(1, 0, At, B0); PG8_MMA(1, 1, At, B1); PG8_BAR; PG8_SCHED;
            PG8_LDB(B0, 1, 0); PG8_LDB(B1, 1, 1); PG8_SCHED; PG8_LDA(At, 1, 0); PG8_STAGE(PG8_SA(0, 1), a2 + hstep, voffA);
            PG8_WAIT_V(8); PG8_WAIT_L(0); PG8_BAR; PG8_MMA(0, 0, At, B0); PG8_MMA(0, 1, At, B1); PG8_BAR; PG8_SCHED;
            PG8_LDA(At, 1, 1); PG8_STAGE(PG8_SB(1, 0), b3, voffB); PG8_STAGE(PG8_SB(1, 1), b3 + hstep, voffB); PG8_STAGE(PG8_SA(1, 0), a3, voffA);
            PG8_WAIT_V(8); PG8_WAIT_L(0); PG8_BAR; PG8_MMA(1, 0, At, B0); PG8_MMA(1, 1, At, B1); PG8_BAR; PG8_SCHED;
            } else {
            PG8_LDB(B0, 0, 0); PG8_SCHED; PG8_LDA(At, 0, 0); PG8_STAGE(PG8_SA(1, 1), a1 + hstep, voffA);
            PG8_WAIT_L(8); PG8_BAR; PG8_WAIT_L(0); PG8_MMA(0, 0, At, B0); PG8_BAR; PG8_SCHED;
            PG8_LDB(B1, 0, 1); PG8_STAGE(PG8_SB(0, 0), b2, voffB);
            PG8_BAR; PG8_WAIT_L(0); PG8_MMA(0, 1, At, B1); PG8_BAR;
            PG8_LDA(At, 0, 1); PG8_STAGE(PG8_SA(0, 0), a2, voffA);
            PG8_BAR; PG8_WAIT_L(0); PG8_MMA(1, 0, At, B0); PG8_BAR; PG8_SCHED;
            PG8_STAGE(PG8_SB(0, 1), b2 + hstep, voffB);
            PG8_WAIT_V(6); PG8_BAR; PG8_MMA(1, 1, At, B1); PG8_BAR;
            PG8_LDB(B0, 1, 0); PG8_SCHED; PG8_LDA(At, 1, 0); PG8_STAGE(PG8_SA(0, 1), a2 + hstep, voffA);
            PG8_WAIT_L(8); PG8_BAR; PG8_WAIT_L(0); PG8_MMA(0, 0, At, B0); PG8_BAR; PG8_SCHED;
            PG8_LDB(B1, 1, 1); PG8_STAGE(PG8_SB(1, 0), b3, voffB);
            PG8_BAR; PG8_WAIT_L(0); PG8_MMA(0, 1, At, B1); PG8_BAR;
            PG8_LDA(At, 1, 1); PG8_STAGE(PG8_SA(1, 0), a3, voffA);
            PG8_BAR; PG8_WAIT_L(0); PG8_MMA(1, 0, At, B0); PG8_BAR; PG8_SCHED;
            PG8_STAGE(PG8_SB(1, 1), b3 + hstep, voffB);
            PG8_WAIT_V(6); PG8_BAR; PG8_MMA(1, 1, At, B1); PG8_BAR;
            }
        }
        if constexpr (ALIGN_EPI) { if (wr == 0) PG8_BAR; }
        if constexpr (!Epi::AFTER_DRAIN) { E(acc, cur, wr, wc, fr, fq); S.done(cur); }
        if (!has_next) break;
#pragma unroll
        for (int a = 0; a < 2; ++a)
#pragma unroll
            for (int b = 0; b < 2; ++b)
#pragma unroll
                for (int m = 0; m < 4; ++m)
#pragma unroll
                    for (int n = 0; n < 2; ++n) acc[a][b][m][n] = (f32x4){0.f, 0.f, 0.f, 0.f};
        cur = nxt; cA = nA; cB = nB; ++ui;
        if constexpr (ALIGN_EPI) { if (wr == 1) PG8_BAR; }
    }
    PG8_WAIT_V(0);
    if constexpr (!ALIGN_EPI) { if (wr == 0) PG8_BAR; }
    PG8_BAR;
    if constexpr (Epi::AFTER_DRAIN) { E.fused(acc, cur, wr, wc, fr, fq, lds, wid, lane); S.done(cur); }
#undef PG8_SA
#undef PG8_SB
#undef PG8_STAGE
#undef PG8_LDA
#undef PG8_LDB
#undef PG8_MMA
#undef PG8_WAIT_V
#undef PG8_WAIT_L
#undef PG8_BAR
#undef PG8_SCHED
}
}

#define LAS __attribute__((address_space(3)))
typedef pg8::bf16_t bf16_t;
typedef pg8::bf16x8 bf16x8;
typedef pg8::f32x4 f32x4;
typedef pg8::u32x4 u32x4;
typedef float f32x16 __attribute__((ext_vector_type(16)));
typedef unsigned u32x2 __attribute__((ext_vector_type(2)));

constexpr int T_TOK = 81920, T_PROMPT = 16384, DM = 1024, INW = 2816, FFW = 2816, NLAYER = 2;
constexpr int S_PROMPT = 2048, S_SAMPLE = 4096;
constexpr float LN_EPS = 1e-5f, ALPHA = 1.4142135623730951f, LOG2E = 1.4426950408889634f;
constexpr float QSCALE = 0.125f * LOG2E;
constexpr size_t MiB = 1u << 20;
constexpr size_t WS_WIN = 0, WS_WOUT = 11 * MiB, WS_WGU = 15 * MiB, WS_WD = 37 * MiB, WS_WSB = 48 * MiB, WS_STAT = 49 * MiB;
constexpr int NSEQ = 24, STAT_L = NSEQ * 32;
constexpr size_t WS_XB = 64 * MiB, WS_MIX = 224 * MiB, WS_H = 384 * MiB, WS_END = 824 * MiB;
constexpr int LDS_BYTES = 147456;

struct Args {
    const float* in[19];
    float* out;
    unsigned char* ws;
};

__device__ __forceinline__ unsigned cvtpk(float lo, float hi) { return pg8::cvt_pk_bf16(lo, hi); }
__device__ __forceinline__ float bf2f(unsigned short h) { return __uint_as_float(((unsigned)h) << 16); }
__device__ __forceinline__ float bflo(unsigned w) { return __uint_as_float(w << 16); }
__device__ __forceinline__ float bfhi(unsigned w) { return __uint_as_float(w & 0xffff0000u); }
__device__ __forceinline__ float fast_exp2(float x) { return __builtin_amdgcn_exp2f(x); }
__device__ __forceinline__ float fast_rcp(float x) { return __builtin_amdgcn_rcpf(x); }
__device__ __forceinline__ float gelu_tanh(float x) {
    const float u = x * (0.7978845608028654f + 0.035677408136300125f * x * x);
    const float e = fast_exp2(-2.0f * LOG2E * u);
    return x * fast_rcp(1.0f + e);
}
__device__ __forceinline__ float silu_f(float x) { return x * fast_rcp(1.0f + fast_exp2(-LOG2E * x)); }
__device__ __forceinline__ float swap_max(float v) {
    auto rr = __builtin_amdgcn_permlane32_swap(__float_as_uint(v), __float_as_uint(v), false, false);
    return fmaxf(__uint_as_float(rr[0]), __uint_as_float(rr[1]));
}
__device__ __forceinline__ float swap_sum(float v) {
    auto rr = __builtin_amdgcn_permlane32_swap(__float_as_uint(v), __float_as_uint(v), false, false);
    return __uint_as_float(rr[0]) + __uint_as_float(rr[1]);
}
__device__ __forceinline__ float wave_sum(float v) {
#pragma unroll
    for (int o = 1; o < 64; o <<= 1) v += __shfl_xor(v, o);
    return v;
}

struct EpiIn {
    static constexpr bool PERM = true, AFTER_DRAIN = false;
    bf16_t* O; unsigned* stat;
    __device__ __forceinline__ void operator()(const f32x4 (&acc)[2][2][4][2], const pg8::Unit& u, int wr, int wc, int fr, int fq) const {
        const int row0 = u.pm * 256 + wr * 64 + fr, col0 = u.pn * 256 + wc * 32 + 8 * fq;
        const bool dog = u.pn < 2;
        const float sc = (u.pn == 2 || u.pn == 3 || u.pn == 8) ? QSCALE : 1.0f;
        const bool dostat = (u.pn >= 2 && u.pn <= 5);
        float best0 = 0.f, best1 = 0.f;
#pragma unroll
        for (int ai = 0; ai < 2; ++ai)
#pragma unroll
            for (int m = 0; m < 4; ++m) {
                bf16_t* rowp = O + (size_t)(row0 + ai * 128 + m * 16) * INW + col0;
#pragma unroll
                for (int bj = 0; bj < 2; ++bj) {
                    f32x4 v0 = acc[ai][bj][m][0], v1 = acc[ai][bj][m][1];
                    if (dog) {
#pragma unroll
                        for (int e = 0; e < 4; ++e) { v0[e] = gelu_tanh(v0[e]); v1[e] = gelu_tanh(v1[e]); }
                    }
                    v0 = v0 * sc; v1 = v1 * sc;
                    u32x4 w; w.x = cvtpk(v0[0], v0[1]); w.y = cvtpk(v0[2], v0[3]); w.z = cvtpk(v1[0], v1[1]); w.w = cvtpk(v1[2], v1[3]);
                    *(u32x4*)(rowp + bj * 128) = w;
                    if (dostat) {
                        float ss = (v0[0] * v0[0] + v0[1] * v0[1]) + (v0[2] * v0[2] + v0[3] * v0[3]) + (v1[0] * v1[0] + v1[1] * v1[1]) + (v1[2] * v1[2] + v1[3] * v1[3]);
                        ss += __shfl_xor(ss, 16); ss += __shfl_xor(ss, 32);
                        if (bj == 0) best0 = fmaxf(best0, ss); else best1 = fmaxf(best1, ss);
                    }
                }
            }
        if (dostat) {
#pragma unroll
            for (int o = 1; o < 16; o <<= 1) { best0 = fmaxf(best0, __shfl_xor(best0, o)); best1 = fmaxf(best1, __shfl_xor(best1, o)); }
            if ((threadIdx.x & 63) == 0) {
                const int seq = (u.pm < 64) ? (u.pm >> 3) : (8 + ((u.pm - 64) >> 4));
                unsigned* sp = stat + seq * 32 + (u.pn - 2) * 8 + wc;
                atomicMax(sp, __float_as_uint(best0)); atomicMax(sp + 4, __float_as_uint(best1));
            }
        }
    }
};
struct EpiGU {
    static constexpr bool PERM = true, AFTER_DRAIN = false;
    bf16_t* O;
    __device__ __forceinline__ void operator()(const f32x4 (&acc)[2][2][4][2], const pg8::Unit& u, int wr, int wc, int fr, int fq) const {
        const int row0 = u.pm * 256 + wr * 64 + fr, col0 = u.pn * 128 + wc * 32 + 8 * fq;
#pragma unroll
        for (int ai = 0; ai < 2; ++ai)
#pragma unroll
            for (int m = 0; m < 4; ++m) {
                bf16_t* rowp = O + (size_t)(row0 + ai * 128 + m * 16) * FFW + col0;
                f32x4 h0, h1;
#pragma unroll
                for (int e = 0; e < 4; ++e) { h0[e] = silu_f(acc[ai][0][m][0][e]) * acc[ai][1][m][0][e]; h1[e] = silu_f(acc[ai][0][m][1][e]) * acc[ai][1][m][1][e]; }
                u32x4 w; w.x = cvtpk(h0[0], h0[1]); w.y = cvtpk(h0[2], h0[3]); w.z = cvtpk(h1[0], h1[1]); w.w = cvtpk(h1[2], h1[3]);
                *(u32x4*)rowp = w;
            }
    }
};
struct EpiRes {
    static constexpr bool PERM = false, AFTER_DRAIN = false;
    float* X;
    __device__ __forceinline__ void operator()(const f32x4 (&acc)[2][2][4][2], const pg8::Unit& u, int wr, int wc, int fr, int fq) const {
        float* base = X + (size_t)(u.pm * 256 + wr * 64 + fr) * DM + u.pn * 256 + wc * 32 + 4 * fq;
#pragma unroll
        for (int ai = 0; ai < 2; ++ai)
#pragma unroll
            for (int m = 0; m < 4; ++m) {
                float* p = base + (size_t)(ai * 128 + m * 16) * DM;
#pragma unroll
                for (int bj = 0; bj < 2; ++bj)
#pragma unroll
                    for (int n = 0; n < 2; ++n) {
                        const f32x4 s = *(const f32x4*)(p + bj * 128 + n * 16);
                        *(f32x4*)(p + bj * 128 + n * 16) = s * ALPHA + acc[ai][bj][m][n];
                    }
                asm volatile("" ::: "memory");
            }
    }
};

__device__ __forceinline__ void transpose_item(const float* W, int K, int N, bf16_t* WT, int mode, LAS float* scr, int item, int lane) {
    const int nblk = N / 32, kb = item / nblk, nb = item % nblk, k0 = 64 * kb, n0 = 32 * nb;
    const int rowbase = (mode == 0) ? n0 : (256 * (n0 / 128) + (n0 % 128) + (mode == 2 ? 128 : 0));
#pragma unroll 8
    for (int i = 0; i < 32; ++i) { const int kk = 2 * i + (lane >> 5); scr[kk * 33 + (lane & 31)] = W[(size_t)(k0 + kk) * N + n0 + (lane & 31)]; }
    asm volatile("s_waitcnt lgkmcnt(0)" ::: "memory");
    const int c = lane & 7;
#pragma unroll
    for (int j = 0; j < 4; ++j) {
        const int n = (lane >> 3) + 8 * j; const LAS float* s = scr + (8 * c) * 33 + n;
        u32x4 o; o.x = cvtpk(s[0 * 33], s[1 * 33]); o.y = cvtpk(s[2 * 33], s[3 * 33]); o.z = cvtpk(s[4 * 33], s[5 * 33]); o.w = cvtpk(s[6 * 33], s[7 * 33]);
        *(u32x4*)(WT + (size_t)(rowbase + n) * K + k0 + 8 * c) = o;
    }
    asm volatile("s_waitcnt lgkmcnt(0)" ::: "memory");
}

__device__ __forceinline__ void prologue(const Args& a, LAS unsigned char* lds) {
    const int tid = fresh_tid(), lane = tid & 63, wave = __builtin_amdgcn_readfirstlane(tid >> 6);
    const int G = gridDim.x, gw = blockIdx.x * 8 + wave, NGW = G * 8;
    LAS float* scr = (LAS float*)(lds + wave * 16384);
    constexpr int I_IN = 16 * 88, I_OUT = 16 * 32, I_G = 16 * 88, I_D = 44 * 32, I_L = I_IN + I_OUT + 2 * I_G + I_D;
    unsigned char* ws = a.ws;
    for (int it = gw; it < NLAYER * I_L; it += NGW) {
        const int l = it / I_L; int r = it % I_L;
        if (r < I_IN) { transpose_item(a.in[2] + (size_t)l * DM * INW, DM, INW, (bf16_t*)(ws + WS_WIN) + (size_t)l * INW * DM, 0, scr, r, lane); continue; } r -= I_IN;
        if (r < I_OUT) { transpose_item(a.in[3] + (size_t)l * DM * DM, DM, DM, (bf16_t*)(ws + WS_WOUT) + (size_t)l * DM * DM, 0, scr, r, lane); continue; } r -= I_OUT;
        if (r < I_G) { transpose_item(a.in[14] + (size_t)l * DM * FFW, DM, FFW, (bf16_t*)(ws + WS_WGU) + (size_t)l * 2 * FFW * DM, 1, scr, r, lane); continue; } r -= I_G;
        if (r < I_G) { transpose_item(a.in[15] + (size_t)l * DM * FFW, DM, FFW, (bf16_t*)(ws + WS_WGU) + (size_t)l * 2 * FFW * DM, 2, scr, r, lane); continue; } r -= I_G;
        transpose_item(a.in[16] + (size_t)l * FFW * DM, FFW, DM, (bf16_t*)(ws + WS_WD) + (size_t)l * DM * FFW, 0, scr, r, lane);
    }
    const int gt = blockIdx.x * 512 + tid, NGT = G * 512;
    for (int i = gt; i < NLAYER * STAT_L; i += NGT) ((unsigned*)(ws + WS_STAT))[i] = 0u;
    for (int i = gt; i < 131072 / 4; i += NGT) {
        const f32x4 v = *(const f32x4*)(a.in[6] + (size_t)i * 4);
        u32x2 o; o.x = cvtpk(v[0], v[1]); o.y = cvtpk(v[2], v[3]);
        *(u32x2*)((bf16_t*)(ws + WS_WSB) + (size_t)i * 4) = o;
    }
    bf16_t* XB = (bf16_t*)(ws + WS_XB);
    for (int i = gt; i < T_TOK * DM / 8; i += NGT) {
        const size_t e = (size_t)i * 8;
        const float* src = (e < (size_t)T_PROMPT * DM) ? (a.in[0] + e) : (a.in[1] + (e - (size_t)T_PROMPT * DM));
        const f32x4 v0 = *(const f32x4*)src, v1 = *(const f32x4*)(src + 4);
        u32x4 o; o.x = cvtpk(v0[0], v0[1]); o.y = cvtpk(v0[2], v0[3]); o.z = cvtpk(v1[0], v1[1]); o.w = cvtpk(v1[2], v1[3]);
        *(u32x4*)(XB + e) = o;
        *(f32x4*)(a.out + e) = v0; *(f32x4*)(a.out + e + 4) = v1;
    }
}

__device__ __forceinline__ void ln_phase(float* X, bf16_t* XB, const float* g, const float* b, bool write_b) {
    const int tid = fresh_tid(), lane = tid & 63, wave = __builtin_amdgcn_readfirstlane(tid >> 6);
    const int gw = blockIdx.x * 8 + wave, NGW = gridDim.x * 8;
    f32x4 gv[4], bv[4];
#pragma unroll
    for (int j = 0; j < 4; ++j) { gv[j] = *(const f32x4*)(g + 4 * lane + 256 * j); bv[j] = *(const f32x4*)(b + 4 * lane + 256 * j); }
    for (int row = gw; row < T_TOK; row += NGW) {
        float* xr = X + (size_t)row * DM + 4 * lane;
        f32x4 v[4]; float s = 0.f;
#pragma unroll
        for (int j = 0; j < 4; ++j) { v[j] = *(const f32x4*)(xr + 256 * j); s += (v[j][0] + v[j][1]) + (v[j][2] + v[j][3]); }
        const float mean = wave_sum(s) * (1.0f / DM); float s2 = 0.f;
#pragma unroll
        for (int j = 0; j < 4; ++j) { v[j] = v[j] - mean; s2 += (v[j][0] * v[j][0] + v[j][1] * v[j][1]) + (v[j][2] * v[j][2] + v[j][3] * v[j][3]); }
        const float rstd = 1.0f / sqrtf(wave_sum(s2) * (1.0f / DM) + LN_EPS);
#pragma unroll
        for (int j = 0; j < 4; ++j) {
            const f32x4 o = v[j] * rstd * gv[j] + bv[j];
            *(f32x4*)(xr + 256 * j) = o;
            if (write_b) { u32x2 w; w.x = cvtpk(o[0], o[1]); w.y = cvtpk(o[2], o[3]); *(u32x2*)(XB + (size_t)row * DM + 4 * lane + 256 * j) = w; }
        }
    }
}

#define MFMA32(a, b, c) __builtin_amdgcn_mfma_f32_32x32x16_bf16((a), (b), (c), 0, 0, 0)
#define MFMA16(a, b, c) __builtin_amdgcn_mfma_f32_16x16x32_bf16((a), (b), (c), 0, 0, 0)

constexpr int SG_P = 272;
__device__ __forceinline__ void sgu_unit(LAS unsigned char* lds, const bf16_t* H, bf16_t* MIX, int chunk, const float* lng, const float* lnb, const bf16_t* wsb, const float* bs) {
    const int tid = fresh_tid(), lane = tid & 63, wave = __builtin_amdgcn_readfirstlane(tid >> 6);
    const int t0 = chunk * 128;
    __syncthreads();
    {
        const int s = tid >> 2, q = tid & 3;
        const bf16_t* src = H + (size_t)(t0 + s) * INW + 256 + 64 * q;
        u32x4 raw[8]; float sum = 0.f;
#pragma unroll
        for (int i = 0; i < 8; ++i) { raw[i] = *(const u32x4*)(src + 8 * i);
#pragma unroll
            for (int e = 0; e < 4; ++e) sum += bflo(raw[i][e]) + bfhi(raw[i][e]); }
        sum += __shfl_xor(sum, 1); sum += __shfl_xor(sum, 2);
        const float mean = sum * (1.0f / 256.0f); float sq = 0.f;
#pragma unroll
        for (int i = 0; i < 8; ++i)
#pragma unroll
            for (int e = 0; e < 4; ++e) { const float a = bflo(raw[i][e]) - mean, b = bfhi(raw[i][e]) - mean; sq += a * a + b * b; }
        sq += __shfl_xor(sq, 1); sq += __shfl_xor(sq, 2);
        const float rstd = 1.0f / sqrtf(sq * (1.0f / 256.0f) + LN_EPS);
#pragma unroll
        for (int i = 0; i < 8; ++i)
#pragma unroll
            for (int e = 0; e < 4; ++e) {
                const int ch = 64 * q + 8 * i + 2 * e;
                const float a = (bflo(raw[i][e]) - mean) * rstd * lng[ch] + lnb[ch];
                const float b = (bfhi(raw[i][e]) - mean) * rstd * lng[ch + 1] + lnb[ch + 1];
                const unsigned w = cvtpk(a, b);
                *(LAS unsigned short*)(lds + ch * SG_P + s * 2) = (unsigned short)(w & 0xffffu);
                *(LAS unsigned short*)(lds + (ch + 1) * SG_P + s * 2) = (unsigned short)(w >> 16);
            }
    }
    __syncthreads();
    {
        const int g = wave >> 1, th = wave & 1, fr = lane & 15, fq = lane >> 4;
        f32x4 acc[4][4];
#pragma unroll
        for (int ct = 0; ct < 4; ++ct)
#pragma unroll
            for (int tt = 0; tt < 4; ++tt) acc[ct][tt] = (f32x4){0.f, 0.f, 0.f, 0.f};
        const bf16_t* wg = wsb + (size_t)g * 128 * 128;
#pragma unroll
        for (int ks = 0; ks < 4; ++ks) {
            bf16x8 xf[4], yf[4];
#pragma unroll
            for (int ct = 0; ct < 4; ++ct) xf[ct] = *(const LAS bf16x8*)(lds + (g * 64 + 16 * ct + fr) * SG_P + (32 * ks + 8 * fq) * 2);
#pragma unroll
            for (int tt = 0; tt < 4; ++tt) yf[tt] = *(const bf16x8*)(wg + (size_t)(64 * th + 16 * tt + fr) * 128 + 32 * ks + 8 * fq);
#pragma unroll
            for (int ct = 0; ct < 4; ++ct)
#pragma unroll
                for (int tt = 0; tt < 4; ++tt) acc[ct][tt] = MFMA16(xf[ct], yf[tt], acc[ct][tt]);
        }
#pragma unroll
        for (int tt = 0; tt < 4; ++tt) {
            const int t = 64 * th + 16 * tt + fr;
            const float bias = bs[g * 128 + t];
#pragma unroll
            for (int ct = 0; ct < 4; ++ct) {
                const int c = g * 64 + 16 * ct + 4 * fq;
                const u32x2 uu = *(const u32x2*)(H + (size_t)(t0 + t) * INW + c);
                const float o0 = bflo(uu.x) * (acc[ct][tt][0] + bias), o1 = bfhi(uu.x) * (acc[ct][tt][1] + bias);
                const float o2 = bflo(uu.y) * (acc[ct][tt][2] + bias), o3 = bfhi(uu.y) * (acc[ct][tt][3] + bias);
                u32x2 w; w.x = cvtpk(o0, o1); w.y = cvtpk(o2, o3);
                *(u32x2*)(MIX + (size_t)(t0 + t) * DM + c) = w;
            }
        }
    }
}

constexpr int KP = 272, VP = 272, ATT_KBUF = 64 * KP, ATT_VBUF = 64 * VP, ATT_BUF = ATT_KBUF + ATT_VBUF, ATT_Q_OFF = 2 * ATT_BUF;
typedef short v4i16_t __attribute__((ext_vector_type(4)));
__device__ __forceinline__ v4i16_t vtr(const LAS unsigned char* p) { return __builtin_amdgcn_ds_read_tr16_b64_v4i16((LAS v4i16_t*)p); }
static_assert(ATT_Q_OFF + 8 * 32 * KP <= LDS_BYTES, "attention LDS map");
__device__ __forceinline__ int perm16(int x) { return (x & 3) | ((x & 4) << 1) | ((x & 8) >> 1); }
__device__ __forceinline__ void dattn_block(LAS unsigned char* kbuf, LAS unsigned char* vbuf, LAS unsigned char* qlds, int c, int kt, bool first, int kb, int q0, float dq, float slope2,
                                            f32x16 (&O)[4], float& negm, float& lrun, int l32, int hi) {
    constexpr float THR = 8.0f, SKIP = -36.0f;
    f32x16 sv;
    float dql = dq - (float)(32 * kt); asm volatile("" : "+v"(dql));
    if (kb + 31 <= q0 || kb >= q0 + 31) {
        const float sg = (kb + 31 <= q0) ? 1.0f : -1.0f;
        const float coef = sg * slope2, base = negm - coef * dql;
#pragma unroll
        for (int j = 0; j < 16; ++j) sv[j] = fmaf(coef, (float)((j & 3) + 8 * (j >> 2)), base);
    } else {
#pragma unroll
        for (int j = 0; j < 16; ++j) sv[j] = fmaf(-slope2, fabsf(dql - (float)((j & 3) + 8 * (j >> 2))), negm);
    }
#pragma unroll
    for (int s = 0; s < 4; ++s) {
        const bf16x8 kf = *(const LAS bf16x8*)(kbuf + (32 * kt + l32) * KP + (c * 64 + s * 16 + hi * 8) * 2);
        const bf16x8 qfr = *(const LAS bf16x8*)(qlds + (c * 64 + s * 16) * 2);
        sv = MFMA32(kf, qfr, sv);
        if (s & 1) __builtin_amdgcn_sched_barrier(0);
    }
    float mx = fmaxf(fmaxf(sv[0], sv[1]), sv[2]);
#pragma unroll
    for (int j = 3; j < 15; j += 2) mx = fmaxf(fmaxf(mx, sv[j]), sv[j + 1]);
    mx = fmaxf(mx, sv[15]);
    mx = swap_max(mx);
    if (first || __any(mx > THR)) {
        const float delta = (first || mx > THR) ? mx : 0.0f;
        const float alpha = fast_exp2(-delta);
        negm -= delta; lrun *= alpha;
#pragma unroll
        for (int j = 0; j < 16; ++j) sv[j] -= delta;
#pragma unroll
        for (int et = 0; et < 4; ++et)
#pragma unroll
            for (int j = 0; j < 16; ++j) asm volatile("v_mul_f32 %0, %0, %1" : "+v"(O[et][j]) : "v"(alpha));
    }
    float ps = 0.f;
#pragma unroll
    for (int j = 0; j < 16; ++j) { sv[j] = fast_exp2(sv[j]); ps += sv[j]; }
    lrun += ps;
    bf16x8 pf0, pf1;
    {
        u32x4 w;
        w.x = cvtpk(sv[0], sv[1]); w.y = cvtpk(sv[2], sv[3]); w.z = cvtpk(sv[4], sv[5]); w.w = cvtpk(sv[6], sv[7]); pf0 = __builtin_bit_cast(bf16x8, w);
        w.x = cvtpk(sv[8], sv[9]); w.y = cvtpk(sv[10], sv[11]); w.z = cvtpk(sv[12], sv[13]); w.w = cvtpk(sv[14], sv[15]); pf1 = __builtin_bit_cast(bf16x8, w);
    }
#pragma unroll
    for (int et = 0; et < 4; ++et) {
        const v4i16_t a0 = vtr(vbuf + (32 * kt) * VP + 64 * et), a1 = vtr(vbuf + (32 * kt + 8) * VP + 64 * et);
        const v4i16_t b0 = vtr(vbuf + (32 * kt + 16) * VP + 64 * et), b1 = vtr(vbuf + (32 * kt + 24) * VP + 64 * et);
        const bf16x8 vf0 = (bf16x8){a0[0], a0[1], a0[2], a0[3], a1[0], a1[1], a1[2], a1[3]};
        const bf16x8 vf1 = (bf16x8){b0[0], b0[1], b0[2], b0[3], b1[0], b1[1], b1[2], b1[3]};
        O[et] = MFMA32(vf0, pf0, O[et]);
        O[et] = MFMA32(vf1, pf1, O[et]);
    }
}
__device__ __forceinline__ void dattn_write_k(LAS unsigned char* kbuf, int kkey0, int kpart, const u32x4& r0, const u32x4& r1) {
    *(LAS u32x4*)(kbuf + kkey0 * KP + kpart * 16) = r0;
    *(LAS u32x4*)(kbuf + (kkey0 + 32) * KP + kpart * 16) = r1;
}
__device__ __forceinline__ void dattn_unit(LAS unsigned char* lds, const bf16_t* H, bf16_t* MIX, int tok0, int S, int h, int qb, float lam, float slope2,
                                           const float* subg, float outscale, int dthr) {
    const int tid = fresh_tid(), lane = tid & 63, wave = __builtin_amdgcn_readfirstlane(tid >> 6), l32 = lane & 31, hi = lane >> 5;
    const int q0 = qb * 256 + wave * 32;
    LAS unsigned char* qlds = lds + ATT_Q_OFF + wave * (32 * KP) + l32 * KP + hi * 16;
    const int kkey0 = tid >> 4, kpart = tid & 15;
    const bf16_t* kg = H + (size_t)(tok0 + kkey0) * INW + 1024 + h * 128 + kpart * 8;
    const bf16_t* vg = kg + 512;
    const int vtr_off = (4 * hi + ((lane & 15) >> 2)) * VP + 32 * ((lane >> 4) & 1) + 8 * (lane & 3);
    const int tmin = (256 * qb - 63 - dthr <= 0) ? 0 : ((256 * qb - 63 - dthr + 63) >> 6);
    const int tmax = min(S / 64 - 1, (256 * qb + 255 + dthr) >> 6);
    const int nt = tmax - tmin + 1;
    __syncthreads();
    {
        const bf16_t* qsrc = H + (size_t)(tok0 + q0) * INW + 512 + h * 128;
#pragma unroll
        for (int i = 0; i < 8; ++i) {
            const int ch = lane + 64 * i, row = ch >> 4, part = ch & 15;
            *(LAS u32x4*)(lds + ATT_Q_OFF + wave * (32 * KP) + row * KP + part * 16) = *(const u32x4*)(qsrc + (size_t)row * INW + part * 8);
        }
    }
    int lo = 4 * qb - 1, hiT = 4 * qb + 4; bool tog = false;
    int tcur = 4 * qb;
    {
        const size_t adv = (size_t)tcur * 64 * INW;
        const u32x4 a0 = *(const u32x4*)(kg + adv), a1 = *(const u32x4*)(kg + adv + (size_t)32 * INW);
        const u32x4 b0 = *(const u32x4*)(vg + adv), b1 = *(const u32x4*)(vg + adv + (size_t)32 * INW);
        dattn_write_k(lds, kkey0, kpart, a0, a1);
        dattn_write_k(lds + ATT_KBUF, kkey0, kpart, b0, b1);
    }
    f32x16 O0[4], O1[4];
#pragma unroll
    for (int et = 0; et < 4; ++et)
#pragma unroll
        for (int j = 0; j < 16; ++j) { O0[et][j] = 0.f; O1[et][j] = 0.f; }
    float negm0 = 0.f, negm1 = 0.f, lrun0 = 0.f, lrun1 = 0.f;
#pragma clang loop unroll(disable)
    for (int step = 0; step < nt; ++step) {
        LAS unsigned char* kb_ = lds + (step & 1) * ATT_BUF;
        LAS unsigned char* vb_ = kb_ + ATT_KBUF;
        LAS unsigned char* kn_ = lds + ((step & 1) ^ 1) * ATT_BUF;
        LAS unsigned char* vn_ = kn_ + ATT_KBUF;
        __syncthreads();
        const int k0 = tcur * 64;
        const bool more = step + 1 < nt;
        size_t adv = 0;
        if (more) {
            int tn;
            if (step + 1 < 4) tn = 4 * qb + step + 1;
            else { const bool takeLo = (lo >= tmin) && (hiT > tmax || tog); tog = !tog; if (takeLo) { tn = lo; --lo; } else { tn = hiT; ++hiT; } }
            tcur = tn;
            adv = (size_t)tn * 64 * INW;
        }
        u32x4 r0, r1;
        if (more) { r0 = *(const u32x4*)(kg + adv); r1 = *(const u32x4*)(kg + adv + (size_t)32 * INW); }
        const float dq = (float)(q0 + l32 - k0 - 4 * hi);
        dattn_block(kb_, vb_ + vtr_off, qlds, 0, 0, step == 0, k0, q0, dq, slope2, O0, negm0, lrun0, l32, hi);
        __builtin_amdgcn_sched_barrier(0);
        if (more) { dattn_write_k(kn_, kkey0, kpart, r0, r1); r0 = *(const u32x4*)(vg + adv); r1 = *(const u32x4*)(vg + adv + (size_t)32 * INW); }
        dattn_block(kb_, vb_ + vtr_off, qlds, 0, 1, false, k0 + 32, q0, dq, slope2, O0, negm0, lrun0, l32, hi);
        __builtin_amdgcn_sched_barrier(0);
        dattn_block(kb_, vb_ + vtr_off, qlds, 1, 0, step == 0, k0, q0, dq, slope2, O1, negm1, lrun1, l32, hi);
        __builtin_amdgcn_sched_barrier(0);
        if (more) dattn_write_k(vn_, kkey0, kpart, r0, r1);
        dattn_block(kb_, vb_ + vtr_off, qlds, 1, 1, false, k0 + 32, q0, dq, slope2, O1, negm1, lrun1, l32, hi);
        __builtin_amdgcn_sched_barrier(0);
    }
    const float r0 = fast_rcp(swap_sum(lrun0)), r1 = lam * fast_rcp(swap_sum(lrun1));
    float ss = 0.f;
#pragma unroll
    for (int et = 0; et < 4; ++et)
#pragma unroll
        for (int j = 0; j < 16; ++j) { const float o = O0[et][j] * r0 - O1[et][j] * r1; O0[et][j] = o; ss += o * o; }
    ss = swap_sum(ss);
    const float rms = outscale / sqrtf(ss * (1.0f / 128.0f) + LN_EPS);
    bf16_t* orow = MIX + (size_t)(tok0 + q0 + l32) * DM + 256 + h * 128;
#pragma unroll
    for (int et = 0; et < 4; ++et)
#pragma unroll
        for (int jq = 0; jq < 4; ++jq) {
            const int e = 32 * et + 8 * jq + 4 * hi;
            const f32x4 gq = *(const f32x4*)(subg + e);
            u32x2 w; w.x = cvtpk(O0[et][4 * jq] * rms * gq[0], O0[et][4 * jq + 1] * rms * gq[1]);
            w.y = cvtpk(O0[et][4 * jq + 2] * rms * gq[2], O0[et][4 * jq + 3] * rms * gq[3]);
            *(u32x2*)(orow + e) = w;
        }
}

constexpr int NA_VP = 144, NA_RPB_OFF = 576 * NA_VP;
__device__ __forceinline__ void na_unit(LAS unsigned char* lds, const bf16_t* H, bf16_t* MIX, int tok0, int rows, int r0, int h, const float* rpb) {
    const int tid = fresh_tid(), lane = tid & 63, wave = __builtin_amdgcn_readfirstlane(tid >> 6), fr = lane & 15, fq = lane >> 4;
    const int rsA = min(max(r0 - 4, 0), rows - 8), rsB = min(max(r0 - 3, 0), rows - 8);
    const int nkeys = (rsB - rsA + 8) * 64;
    LAS float* rpbl = (LAS float*)(lds + NA_RPB_OFF);
    __syncthreads();
    {
        const bf16_t* vsrc = H + (size_t)(tok0 + rsA * 64) * INW + 2560 + h * 64;
        for (int c = tid; c < nkeys * 8; c += 512) {
            const int key = c >> 3, part = c & 7;
            *(LAS u32x4*)(lds + key * NA_VP + part * 16) = *(const u32x4*)(vsrc + (size_t)key * INW + part * 8);
        }
        for (int i = tid; i < 465; i += 512) rpbl[i] = rpb[h * 465 + i] * LOG2E;
    }
    __syncthreads();
    const int rsel = wave >> 2, cgp = wave & 3;
    const int r = r0 + rsel, rs = rsel ? rsB : rsA;
    const int kc0 = (cgp == 0) ? 0 : (cgp == 1) ? 8 : (cgp == 2) ? 24 : 32;
    const int col = 16 * cgp + fr;
    const int qtok = tok0 + r * 64 + col;
    bf16x8 qf[2];
#pragma unroll
    for (int ks = 0; ks < 2; ++ks) qf[ks] = *(const bf16x8*)(H + (size_t)qtok * INW + 2048 + h * 64 + ks * 32 + fq * 8);
    f32x4 sc[8][2];
    const bf16_t* kbase = H + (size_t)(tok0 + rs * 64 + kc0 + fr) * INW + 2304 + h * 64 + fq * 8;
#pragma unroll
    for (int i = 0; i < 8; ++i)
#pragma unroll
        for (int t = 0; t < 2; ++t) {
            const bf16_t* kp = kbase + (size_t)(i * 64 + 16 * t) * INW;
            const bf16x8 k0 = *(const bf16x8*)kp, k1 = *(const bf16x8*)(kp + 32);
            f32x4 a = (f32x4){0.f, 0.f, 0.f, 0.f};
            a = MFMA16(k0, qf[0], a); a = MFMA16(k1, qf[1], a);
            sc[i][t] = a;
        }
    const int cs = min(max(col - 8, 0), 48);
    float mx = -1e30f;
#pragma unroll
    for (int i = 0; i < 8; ++i) {
        const int row_off = rs + i - r + 7;
#pragma unroll
        for (int t = 0; t < 2; ++t)
#pragma unroll
            for (int ii = 0; ii < 4; ++ii) {
                const int kc = kc0 + 16 * t + 4 * fq + ii;
                const bool valid = (kc >= cs) && (kc < cs + 16);
                const int col_off = valid ? (kc - col + 15) : 0;
                const float v = valid ? (sc[i][t][ii] + rpbl[row_off * 31 + col_off]) : -1e30f;
                sc[i][t][ii] = v; mx = fmaxf(mx, v);
            }
    }
    mx = fmaxf(mx, __shfl_xor(mx, 16)); mx = fmaxf(mx, __shfl_xor(mx, 32));
    float sum = 0.f;
#pragma unroll
    for (int i = 0; i < 8; ++i)
#pragma unroll
        for (int t = 0; t < 2; ++t)
#pragma unroll
            for (int ii = 0; ii < 4; ++ii) { const float p = fast_exp2(sc[i][t][ii] - mx); sc[i][t][ii] = p; sum += p; }
    sum += __shfl_xor(sum, 16); sum += __shfl_xor(sum, 32);
    const float rinv = fast_rcp(sum);
    f32x4 o[4];
#pragma unroll
    for (int et = 0; et < 4; ++et) o[et] = (f32x4){0.f, 0.f, 0.f, 0.f};
    const LAS unsigned char* vtrp = lds + ((rs - rsA) * 64 + kc0 + 4 * fq + (fr >> 2)) * NA_VP + (fr & 3) * 8;
#pragma unroll
    for (int i = 0; i < 8; ++i) {
        u32x4 w; w.x = cvtpk(sc[i][0][0], sc[i][0][1]); w.y = cvtpk(sc[i][0][2], sc[i][0][3]); w.z = cvtpk(sc[i][1][0], sc[i][1][1]); w.w = cvtpk(sc[i][1][2], sc[i][1][3]);
        const bf16x8 pf = __builtin_bit_cast(bf16x8, w);
#pragma unroll
        for (int et = 0; et < 4; ++et) {
            const v4i16_t a0 = vtr(vtrp + (i * 64) * NA_VP + 32 * et), a1 = vtr(vtrp + (i * 64 + 16) * NA_VP + 32 * et);
            const bf16x8 vf = (bf16x8){a0[0], a0[1], a0[2], a0[3], a1[0], a1[1], a1[2], a1[3]};
            o[et] = MFMA16(vf, pf, o[et]);
        }
    }
    bf16_t* orow = MIX + (size_t)qtok * DM + 768 + h * 64 + 4 * fq;
#pragma unroll
    for (int et = 0; et < 4; ++et) {
        u32x2 w; w.x = cvtpk(o[et][0] * rinv, o[et][1] * rinv); w.y = cvtpk(o[et][2] * rinv, o[et][3] * rinv);
        *(u32x2*)(orow + 16 * et) = w;
    }
}

__global__ void __launch_bounds__(512, 2) fwd_megakernel(Args a) {
    extern __shared__ __attribute__((aligned(16))) unsigned char lds_raw[];
    LAS unsigned char* lds = (LAS unsigned char*)lds_raw;
    cg::grid_group grid = cg::this_grid();
    const int G = gridDim.x, bx = blockIdx.x;
    unsigned char* ws = a.ws;
    bf16_t* XB = (bf16_t*)(ws + WS_XB); bf16_t* MIX = (bf16_t*)(ws + WS_MIX); bf16_t* Hb = (bf16_t*)(ws + WS_H);
    float* OUT = a.out;

    prologue(a, lds);
    grid.sync();

    for (int l = 0; l < NLAYER; ++l) {
        {
            pg8::Gemm g{XB, (const bf16_t*)(ws + WS_WIN) + (size_t)l * INW * DM, T_TOK, INW, DM};
            pg8::StaticOrder S; S.init(T_TOK, INW, G, bx);
            EpiIn E{Hb, (unsigned*)(ws + WS_STAT) + l * STAT_L};
            pg8::gemm_phase<EpiIn, pg8::StaticOrder, true, true>(lds, g, S, E);
        }
        grid.sync();
        {
            const int lane = fresh_tid() & 63;
            const float lam_init = (l == 0) ? 0.2f : (0.8f - 0.6f * 0.7408182206817179f);
            const float s1 = wave_sum(a.in[8][l * 64 + lane] * a.in[9][l * 64 + lane]);
            const float s2 = wave_sum(a.in[10][l * 64 + lane] * a.in[11][l * 64 + lane]);
            const float lam = __uint_as_float(__builtin_amdgcn_readfirstlane(__float_as_uint(expf(s1) - expf(s2) + lam_init)));
            const float* subg = a.in[12] + l * 128;
            const float* stat = (const float*)(ws + WS_STAT) + l * STAT_L;
            for (int u = bx; u < 1280; u += G) {
                int tok0, S, h, qb, seq;
                if (u < 1024) {
                    const int j = u >> 8, uu = u & 255, xx = uu & 7, mm = uu >> 3; const int t = xx * 2 + (mm >> 4);
                    seq = 8 + 4 * j + (t >> 2); h = ((t & 3) + j) & 3; qb = ((mm & 15) + 5 * j) & 15; S = S_SAMPLE; tok0 = T_PROMPT + (seq - 8) * S_SAMPLE;
                } else { const int uu = u - 1024, xx = uu & 7, mm = uu >> 3; const int bh = xx * 4 + (mm >> 3); qb = mm & 7; S = S_PROMPT; seq = bh >> 2; tok0 = seq * S_PROMPT; h = bh & 3; }
                const float slope2 = LOG2E * ((h == 0) ? 0.25f : (h == 1) ? 0.0625f : (h == 2) ? 0.015625f : 0.00390625f);
                const float* sq = stat + seq * 32 + 4 * h; const float* sk = sq + 16;
                const float b0 = sqrtf((sq[0] + sq[1]) * (sk[0] + sk[1])), b1 = sqrtf((sq[2] + sq[3]) * (sk[2] + sk[3]));
                const float Bn = 1.02f * fmaxf(b0, b1) + 0.01f;
                const float dth = fminf((2.0f * Bn + 36.0f) / slope2 + 1.0f, 1.0e6f);
                const int dthr = __builtin_amdgcn_readfirstlane((int)dth);
                dattn_unit(lds, Hb, MIX, tok0, S, h, qb, lam, slope2, subg, 1.0f - lam_init, dthr);
            }
            for (int c = bx; c < T_TOK / 128; c += G)
                sgu_unit(lds, Hb, MIX, c, a.in[4] + l * 256, a.in[5] + l * 256, (const bf16_t*)(ws + WS_WSB) + (size_t)l * 4 * 128 * 128, a.in[7] + l * 512);
            for (int U = bx; U < (T_TOK / 128) * 4; U += G) {
                const int rp = U >> 2, hh = U & 3;
                int tok0, rows, r0;
                if (rp < 128) { tok0 = (rp >> 4) * S_PROMPT; rows = 32; r0 = (rp & 15) * 2; }
                else { const int q = rp - 128; tok0 = T_PROMPT + (q >> 5) * S_SAMPLE; rows = 64; r0 = (q & 31) * 2; }
                na_unit(lds, Hb, MIX, tok0, rows, r0, hh, a.in[13] + l * 4 * 15 * 31);
            }
        }
        grid.sync();
        {
            pg8::Gemm g{MIX, (const bf16_t*)(ws + WS_WOUT) + (size_t)l * DM * DM, T_TOK, DM, DM};
            pg8::StaticOrder S; S.init(T_TOK, DM, G, bx);
            EpiRes E{OUT};
            pg8::gemm_phase<EpiRes, pg8::StaticOrder, true, true>(lds, g, S, E);
        }
        grid.sync();
        ln_phase(OUT, XB, a.in[17] + (l * 2 + 0) * DM, a.in[18] + (l * 2 + 0) * DM, true);
        grid.sync();
        {
            pg8::Gemm g{XB, (const bf16_t*)(ws + WS_WGU) + (size_t)l * 2 * FFW * DM, T_TOK, 2 * FFW, DM};
            pg8::StaticOrder S; S.init(T_TOK, 2 * FFW, G, bx);
            EpiGU E{Hb};
            pg8::gemm_phase<EpiGU, pg8::StaticOrder, true, true>(lds, g, S, E);
        }
        grid.sync();
        {
            pg8::Gemm g{Hb, (const bf16_t*)(ws + WS_WD) + (size_t)l * DM * FFW, T_TOK, DM, FFW};
            pg8::StaticOrder S; S.init(T_TOK, DM, G, bx);
            EpiRes E{OUT};
            pg8::gemm_phase<EpiRes, pg8::StaticOrder, true, true>(lds, g, S, E);
        }
        grid.sync();
        ln_phase(OUT, XB, a.in[17] + (l * 2 + 1) * DM, a.in[18] + (l * 2 + 1) * DM, l + 1 < NLAYER);
        if (l + 1 < NLAYER) grid.sync();
    }
}

extern "C" void kernel_launch(void* const* d_in, const int* in_sizes, int n_in, void* d_out, int out_size, void* d_ws, size_t ws_size, hipStream_t stream) {
    static int grid_blocks = 0;
    if (grid_blocks == 0) {
        if (n_in != 19 || ws_size < WS_END) { fprintf(stderr, "kernel_launch: unexpected n_in %d / ws_size %zu\n", n_in, ws_size); grid_blocks = -1; return; }
        int dev = 0, cus = 0, per_cu = 0;
        hipGetDevice(&dev);
        hipDeviceGetAttribute(&cus, hipDeviceAttributeMultiprocessorCount, dev);
        if (hipFuncSetAttribute((const void*)fwd_megakernel, hipFuncAttributeMaxDynamicSharedMemorySize, LDS_BYTES) != hipSuccess) fprintf(stderr, "kernel_launch: hipFuncSetAttribute failed\n");
        if (hipOccupancyMaxActiveBlocksPerMultiprocessor(&per_cu, (const void*)fwd_megakernel, 512, LDS_BYTES) != hipSuccess || per_cu < 1) { fprintf(stderr, "kernel_launch: occupancy query says %d\n", per_cu); per_cu = 1; }
        (void)hipGetLastError();
        grid_blocks = cus * per_cu;
    }
    if (grid_blocks < 0) return;
    Args a{};
    for (int i = 0; i < 19; ++i) a.in[i] = (const float*)d_in[i];
    a.out = (float*)d_out; a.ws = (unsigned char*)d_ws;
    void* args[] = {&a};
    hipError_t e = hipLaunchCooperativeKernel((const void*)fwd_megakernel, dim3(grid_blocks), dim3(512), args, LDS_BYTES, stream);
    if (e != hipSuccess) fprintf(stderr, "cooperative launch failed: %s (grid %d)\n", hipGetErrorString(e), grid_blocks);
}
```
